# Optimizing an MI355X kernel written in HIP

```python
import jax, jax.numpy as jnp
from jax import lax
import numpy as np

D_MODEL = 1024
BATCH = 8
SEQ = 4096
DEPTH = 4

GRID_W = 64
CTX_LEN = 256
EPS = 1e-6

N_MIXERS = 3
POOL_SLOT, ATTN_SLOT, SGU_SLOT = 0, 1, 2
N_POOL_LAYERS = len(range(POOL_SLOT, DEPTH, N_MIXERS))
N_ATTN_LAYERS = len(range(ATTN_SLOT, DEPTH, N_MIXERS))
N_SGU_LAYERS = len(range(SGU_SLOT, DEPTH, N_MIXERS))
CTX_LAST_READER = max([i for i in range(DEPTH) if i % N_MIXERS == ATTN_SLOT], default=-1)

POOL_WINDOWS = (2, 4, 8, 16)
POOL_GROUPS = len(POOL_WINDOWS)
POOL_CH = D_MODEL // POOL_GROUPS

HEAD_DIM = 64
N_Q_HEADS = D_MODEL // HEAD_DIM
N_KV_HEADS = 4
Q_PER_KV = N_Q_HEADS // N_KV_HEADS
Q_DIM = N_Q_HEADS * HEAD_DIM
KV_DIM = N_KV_HEADS * HEAD_DIM
QKV_DIM = Q_DIM + 2 * KV_DIM
ROPE_THETA = 10000.0
ROPE_AXIS_DIM = HEAD_DIM // 2
Q_BLOCK = 128

CHUNK = 128
SGU_WIDTH = D_MODEL
SGU_CH = 128
SGU_GROUPS = SGU_WIDTH // SGU_CH

N_EXPERT_GROUPS = 4
EXPERTS_PER_GROUP = 4
N_EXPERTS = N_EXPERT_GROUPS * EXPERTS_PER_GROUP
TOPK_IN_GROUP = 2
D_EXPERT = 256

kernel_name = "hybrid_pool_gqa_gmlp_hmoe_dit"


def rmsnorm(x, g):
    xf = x.astype(jnp.float32)
    y = xf * lax.rsqrt(jnp.mean(xf * xf, axis=-1, keepdims=True) + EPS)
    return (y * g.astype(jnp.float32)).astype(x.dtype)


def layernorm(x, g, b):
    xf = x.astype(jnp.float32)
    mu = jnp.mean(xf, axis=-1, keepdims=True)
    xc = xf - mu
    var = jnp.mean(xc * xc, axis=-1, keepdims=True)
    return (xc * lax.rsqrt(var + EPS) * g.astype(jnp.float32) + b.astype(jnp.float32)).astype(x.dtype)


def adaln(cvec, w_mod, b_mod):
    m = jax.nn.silu(cvec) @ w_mod + b_mod
    m = m.reshape(cvec.shape[:-1] + (6, 1, D_MODEL))
    return tuple(m[..., k, :, :] for k in range(6))


def modulate(x, g, shift, scale):
    return rmsnorm(x, g) * (1.0 + scale) + shift


def rope_tables(rows):
    row = jnp.repeat(jnp.arange(rows), GRID_W)
    col = jnp.tile(jnp.arange(GRID_W), rows)
    inv = ROPE_THETA ** (-jnp.arange(0, ROPE_AXIS_DIM, 2, dtype=jnp.float32) / ROPE_AXIS_DIM)
    ang = jnp.stack([row, col], axis=-1).astype(jnp.float32)[..., None] * inv
    return jnp.cos(ang), jnp.sin(ang)


def apply_rope(x, cos, sin):
    B, n, H, _ = x.shape
    xr = x.astype(jnp.float32).reshape(B, n, H, 2, 2, ROPE_AXIS_DIM // 2)
    x1, x2 = xr[..., 0, :], xr[..., 1, :]
    c, s = cos[:, None], sin[:, None]
    out = jnp.stack([x1 * c - x2 * s, x2 * c + x1 * s], axis=-2)
    return out.reshape(x.shape).astype(x.dtype)


def pool_mixer(h, w_pool, b_pool, ls):
    B, n, _ = h.shape
    t = jnp.arange(n)
    hf = h.astype(jnp.float32)
    outs = []
    for g, w in enumerate(POOL_WINDOWS):
        xg = hf[..., g * POOL_CH:(g + 1) * POOL_CH]
        cs = jnp.concatenate([jnp.zeros_like(xg[:, :1]), jnp.cumsum(xg, axis=1)], axis=1)
        lo = jnp.clip(t - w // 2, 0, n)
        hi = jnp.clip(t + w // 2, 0, n)
        mean = (cs[:, hi] - cs[:, lo]) / (hi - lo).astype(jnp.float32)[:, None]
        outs.append(mean - xg)
    p = jnp.stack(outs, axis=2).astype(h.dtype)
    y = jnp.einsum('bngc,gcd->bngd', p, w_pool) + b_pool
    return y.reshape(h.shape) * ls


def attn_mixer(h_lat, h_ctx, w_qkv, q_g, k_g, w_o, cos, sin, ctx_out):
    B, S, _ = h_lat.shape
    L = h_ctx.shape[1]
    scale = HEAD_DIM ** -0.5
    qkv = h_lat @ w_qkv
    q = rmsnorm(qkv[..., :Q_DIM].reshape(B, S, N_Q_HEADS, HEAD_DIM), q_g)
    k = rmsnorm(qkv[..., Q_DIM:Q_DIM + KV_DIM].reshape(B, S, N_KV_HEADS, HEAD_DIM), k_g)
    v = qkv[..., Q_DIM + KV_DIM:].reshape(B, S, N_KV_HEADS, HEAD_DIM)
    q = apply_rope(q, cos, sin)
    k = apply_rope(k, cos, sin)
    kv_c = h_ctx @ w_qkv[:, Q_DIM:]
    k_c = rmsnorm(kv_c[..., :KV_DIM].reshape(B, L, N_KV_HEADS, HEAD_DIM), k_g)
    v_c = kv_c[..., KV_DIM:].reshape(B, L, N_KV_HEADS, HEAD_DIM)
    k_all = jnp.concatenate([k_c, k], axis=1)
    v_all = jnp.concatenate([v_c, v], axis=1)
    qb = (q * scale).reshape(B, S // Q_BLOCK, Q_BLOCK, N_KV_HEADS, Q_PER_KV, HEAD_DIM)
    qb = jnp.moveaxis(qb, 1, 0)

    def block(q_blk):
        s = jnp.einsum('bqhgd,bkhd->bhgqk', q_blk, k_all).astype(jnp.float32)
        p = jax.nn.softmax(s, axis=-1).astype(v_all.dtype)
        return jnp.einsum('bhgqk,bkhd->bqhgd', p, v_all)

    o = jnp.moveaxis(lax.map(block, qb), 0, 1).reshape(B, S, Q_DIM)
    y_lat = o @ w_o
    y_ctx = None
    if ctx_out:
        q_c = rmsnorm((h_ctx @ w_qkv[:, :Q_DIM]).reshape(B, L, N_Q_HEADS, HEAD_DIM), q_g)
        q_c = (q_c * scale).reshape(B, L, N_KV_HEADS, Q_PER_KV, HEAD_DIM)
        s_c = jnp.einsum('bqhgd,bkhd->bhgqk', q_c, k_c).astype(jnp.float32)
        p_c = jax.nn.softmax(s_c, axis=-1).astype(v_c.dtype)
        y_ctx = jnp.einsum('bhgqk,bkhd->bqhgd', p_c, v_c).reshape(B, L, Q_DIM) @ w_o
    return y_lat, y_ctx


def sgu_mixer(h, w_in, b_in, ln_g, ln_b, w_s, b_s, w_out):
    B, n, _ = h.shape
    z = jax.nn.gelu(h @ w_in + b_in)
    u, v = z[..., :SGU_WIDTH], z[..., SGU_WIDTH:]
    v = layernorm(v, ln_g, ln_b)
    vc = v.reshape(B, n // CHUNK, CHUNK, SGU_GROUPS, SGU_CH)
    sv = jnp.einsum('gpq,bcqgk->bcpgk', w_s, vc) + b_s.T[:, :, None]
    return (u * sv.reshape(B, n, SGU_WIDTH)) @ w_out


def hier_moe(h, w_rg, b_rg, w_re, b_re, w_gate, w_up, w_down):
    shp = h.shape
    hf = h.reshape(-1, D_MODEL)
    n = hf.shape[0]
    g_logits = (hf @ w_rg).astype(jnp.float32) + b_rg
    g_prob = jax.nn.softmax(g_logits, axis=-1)
    g_sel = jnp.argmax(g_logits, axis=-1)
    g_w = jnp.take_along_axis(g_prob, g_sel[:, None], axis=-1)
    e_logits = ((hf @ w_re).astype(jnp.float32) + b_re).reshape(n, N_EXPERT_GROUPS, EXPERTS_PER_GROUP)
    e_in = jnp.take_along_axis(e_logits, g_sel[:, None, None], axis=1)[:, 0]
    top_v, top_i = lax.top_k(e_in, TOPK_IN_GROUP)
    e_w = jax.nn.softmax(top_v, axis=-1) * g_w
    expert_id = g_sel[:, None] * EXPERTS_PER_GROUP + top_i
    gates = jnp.sum(jax.nn.one_hot(expert_id, N_EXPERTS, dtype=jnp.float32) * e_w[..., None], axis=1)
    a = jnp.einsum('nd,edf->nef', hf, w_gate)
    b = jnp.einsum('nd,edf->nef', hf, w_up)
    hid = jax.nn.silu(a) * b * gates.astype(h.dtype)[..., None]
    return jnp.einsum('nef,efd->nd', hid, w_down).reshape(shp)


def setup_inputs(seed: int = 0) -> dict:
    key = jax.random.key(seed)
    ks = iter(jax.random.split(key, 40))
    D = D_MODEL

    def nrm(shape, scale):
        return jax.random.normal(next(ks), shape, jnp.float32) * scale

    return {
        "x": nrm((BATCH, SEQ, D), 1.0),
        "c": nrm((BATCH, D), 1.0),
        "ctx": nrm((BATCH, CTX_LEN, D), 1.0),
        "c_ctx": nrm((D,), 1.0),
        "w_mod": nrm((DEPTH, D, 6 * D), 0.5 * D ** -0.5),
        "b_mod": nrm((DEPTH, 6 * D), 0.02),
        "norm1_g": 1.0 + nrm((DEPTH, D), 0.02),
        "norm2_g": 1.0 + nrm((DEPTH, D), 0.02),
        "pool_w": nrm((N_POOL_LAYERS, POOL_GROUPS, POOL_CH, POOL_CH), POOL_CH ** -0.5),
        "pool_b": nrm((N_POOL_LAYERS, POOL_GROUPS, POOL_CH), 0.02),
        "pool_ls": 1.0 + nrm((N_POOL_LAYERS, D), 0.02),
        "attn_wqkv": nrm((N_ATTN_LAYERS, D, QKV_DIM), D ** -0.5),
        "attn_qg": 1.0 + nrm((N_ATTN_LAYERS, HEAD_DIM), 0.02),
        "attn_kg": 1.0 + nrm((N_ATTN_LAYERS, HEAD_DIM), 0.02),
        "attn_wo": nrm((N_ATTN_LAYERS, Q_DIM, D), Q_DIM ** -0.5),
        "sgu_win": nrm((N_SGU_LAYERS, D, 2 * SGU_WIDTH), D ** -0.5),
        "sgu_bin": nrm((N_SGU_LAYERS, 2 * SGU_WIDTH), 0.02),
        "sgu_lng": 1.0 + nrm((N_SGU_LAYERS, SGU_WIDTH), 0.02),
        "sgu_lnb": nrm((N_SGU_LAYERS, SGU_WIDTH), 0.02),
        "sgu_ws": nrm((N_SGU_LAYERS, SGU_GROUPS, CHUNK, CHUNK), CHUNK ** -0.5),
        "sgu_bs": 1.0 + nrm((N_SGU_LAYERS, SGU_GROUPS, CHUNK), 0.02),
        "sgu_wout": nrm((N_SGU_LAYERS, SGU_WIDTH, D), SGU_WIDTH ** -0.5),
        "moe_wrg": nrm((DEPTH, D, N_EXPERT_GROUPS), D ** -0.5),
        "moe_brg": nrm((DEPTH, N_EXPERT_GROUPS), 0.01),
        "moe_wre": nrm((DEPTH, D, N_EXPERTS), D ** -0.5),
        "moe_bre": nrm((DEPTH, N_EXPERTS), 0.01),
        "moe_wg": nrm((DEPTH, N_EXPERTS, D, D_EXPERT), D ** -0.5),
        "moe_wu": nrm((DEPTH, N_EXPERTS, D, D_EXPERT), D ** -0.5),
        "moe_wd": nrm((DEPTH, N_EXPERTS, D_EXPERT, D), D_EXPERT ** -0.5),
    }


def reference(x, c, ctx, c_ctx, w_mod, b_mod, norm1_g, norm2_g, pool_w, pool_b, pool_ls,
              attn_wqkv, attn_qg, attn_kg, attn_wo, sgu_win, sgu_bin, sgu_lng, sgu_lnb, sgu_ws, sgu_bs,
              sgu_wout, moe_wrg, moe_brg, moe_wre, moe_bre, moe_wg, moe_wu, moe_wd):
    rows = x.shape[1] // GRID_W
    cos, sin = rope_tables(rows)
    s = ctx
    for i in range(DEPTH):
        kind = i % N_MIXERS
        j = i // N_MIXERS
        ctx_in = i <= CTX_LAST_READER
        ctx_upd = i < CTX_LAST_READER
        sh1, sc1, g1, sh2, sc2, g2 = adaln(c, w_mod[i], b_mod[i])
        a_lat = modulate(x, norm1_g[i], sh1, sc1)
        if ctx_in:
            csh1, csc1, cg1, csh2, csc2, cg2 = adaln(c_ctx, w_mod[i], b_mod[i])
            a_ctx = modulate(s, norm1_g[i], csh1, csc1)
        if kind == POOL_SLOT:
            y_lat = pool_mixer(a_lat, pool_w[j], pool_b[j], pool_ls[j])
            if ctx_upd:
                y_ctx = pool_mixer(a_ctx, pool_w[j], pool_b[j], pool_ls[j])
        elif kind == ATTN_SLOT:
            y_lat, y_ctx = attn_mixer(a_lat, a_ctx, attn_wqkv[j], attn_qg[j], attn_kg[j], attn_wo[j],
                                      cos, sin, ctx_upd)
        else:
            y_lat = sgu_mixer(a_lat, sgu_win[j], sgu_bin[j], sgu_lng[j], sgu_lnb[j], sgu_ws[j], sgu_bs[j],
                              sgu_wout[j])
            if ctx_upd:
                y_ctx = sgu_mixer(a_ctx, sgu_win[j], sgu_bin[j], sgu_lng[j], sgu_lnb[j], sgu_ws[j],
                                  sgu_bs[j], sgu_wout[j])
        x = x + g1 * y_lat
        x = x + g2 * hier_moe(modulate(x, norm2_g[i], sh2, sc2), moe_wrg[i], moe_brg[i], moe_wre[i],
                              moe_bre[i], moe_wg[i], moe_wu[i], moe_wd[i])
        if ctx_upd:
            s = s + cg1 * y_ctx
            s = s + cg2 * hier_moe(modulate(s, norm2_g[i], csh2, csc2), moe_wrg[i], moe_brg[i],
                                   moe_wre[i], moe_bre[i], moe_wg[i], moe_wu[i], moe_wd[i])
    return x
```

```cpp
#include <hip/hip_runtime.h>
#include <cstdio>
#include <cstdint>
namespace mk {
#define LAS __attribute__((address_space(3)))
#define GAS __attribute__((address_space(1)))
typedef unsigned short bf16_t;
typedef short bf16x8 __attribute__((ext_vector_type(8)));
typedef float f32x4 __attribute__((ext_vector_type(4)));
typedef float f32x2 __attribute__((ext_vector_type(2)));
typedef unsigned u32x4 __attribute__((ext_vector_type(4)));
typedef unsigned u32x2 __attribute__((ext_vector_type(2)));
typedef int i32x4 __attribute__((ext_vector_type(4)));
typedef GAS unsigned gu32;
#define RLX_AGENT __ATOMIC_RELAXED, __HIP_MEMORY_SCOPE_AGENT
#define LDS_WAIT() asm volatile("s_waitcnt lgkmcnt(0)" ::: "memory")
#define VM_WAIT() asm volatile("s_waitcnt vmcnt(0)" ::: "memory")

constexpr int D = 1024, NLAT = 32768, NCTX = 2048, NROW = NLAT + NCTX, SEQ = 4096, CTXL = 256, KVROWS = SEQ + CTXL, KVP = 256;
constexpr float EPS = 1e-6f;
constexpr int NWAVES = 8, NTHR = 512;
constexpr int NPHASE = 25;

constexpr size_t MiB = 1u << 20;
constexpr size_t WS_CTL = 0, CTL_ZERO_BYTES = 1 * MiB;
constexpr size_t WS_MOD = 1 * MiB;
constexpr size_t WS_COS = WS_MOD + 896 * 1024, WS_SIN = WS_COS + 4096;
constexpr size_t WS_WQKV = 2 * MiB, WS_WO = 5 * MiB, WS_WIN = 7 * MiB, WS_WOUT = 11 * MiB, WS_WPOOL = 13 * MiB, WS_WSP = 14 * MiB;
constexpr size_t WS_WGU = 16 * MiB, WS_WD = 80 * MiB;
constexpr size_t WS_XC = 112 * MiB;
constexpr size_t WS_A = 120 * MiB, WS_H2 = 188 * MiB;
constexpr size_t WS_BIG = 256 * MiB;
constexpr size_t WS_Q = WS_BIG, WS_K = WS_BIG + 64 * MiB, WS_V = WS_BIG + 82 * MiB;
constexpr size_t WS_U = WS_BIG, WS_VS = WS_BIG + 64 * MiB;
constexpr size_t WS_HID = WS_BIG, WS_LIST = WS_BIG + 48 * MiB;
constexpr size_t WS_END = 384 * MiB;
constexpr int LIST_CAP = NROW;
constexpr int CW_TMO = 0, CW_CODE = 1, CW_BAR = 4096, CW_CNT = 8192;

constexpr int RING_BYTES = 131072, LDSCTL_OFF = RING_BYTES, MISC_OFF = LDSCTL_OFF + 320, TAB_OFF = MISC_OFF + 128;
constexpr int LDS_BYTES = 147456;

__device__ __forceinline__ unsigned cvt_pk_bf16(float lo, float hi) { unsigned r; asm volatile("v_cvt_pk_bf16_f32 %0, %1, %2" : "=v"(r) : "v"(lo), "v"(hi)); return r; }
__device__ __forceinline__ int fresh_tid() { int t = threadIdx.x; asm volatile("" : "+v"(t)); return t; }
__device__ __forceinline__ float bf2f(unsigned h) { return __uint_as_float(h << 16); }
__device__ __forceinline__ float wave_sum(float v) {
#pragma unroll
    for (int o = 1; o < 64; o <<= 1) v += __shfl_xor(v, o);
    return v;
}

#define XB_TMO      128
#define XB_XCNT(j)  (256  + 64 * (j))
#define XB_XSUB(j)  (1280 + 64 * (j))
#define XB_XGEN(j)  (2304 + 64 * (j))
#define XB_TOP      3328
#define XB_TOPGEN   3392
#define XCD_BAR_WORDS 3456
#define XB_SPIN_CAP (1u << 18)
__device__ __forceinline__ unsigned xb_ld(unsigned* p)              { return __hip_atomic_load(p, __ATOMIC_RELAXED, __HIP_MEMORY_SCOPE_AGENT); }
__device__ __forceinline__ unsigned xb_add(unsigned* p, unsigned v) { return __hip_atomic_fetch_add(p, v, __ATOMIC_RELAXED, __HIP_MEMORY_SCOPE_AGENT); }
__device__ __forceinline__ unsigned xb_xcc_id() { return (unsigned)__builtin_amdgcn_s_getreg((3 << 11) | 20) & 0xFu; }
#define XB_SPIN(cond, bar) do { unsigned _sp = 0; while (cond) { __builtin_amdgcn_s_sleep(1); \
    if ((++_sp & 255u) == 0u) { if (xb_ld(&(bar)[XB_TMO])) break; if (_sp > XB_SPIN_CAP) { atomicAdd(&(bar)[XB_TMO], 1u); break; } } } } while (0)
struct XcdBarrier { unsigned* bar; unsigned x; volatile LAS unsigned* st; };
__device__ __forceinline__ XcdBarrier xcd_barrier_post(unsigned* bar, volatile LAS unsigned* st) {
    XcdBarrier b; b.bar = bar; b.x = xb_xcc_id(); b.st = st;
    if (threadIdx.x == 0) (void)xb_add(&bar[XB_XCNT(b.x)], 1u);
    return b;
}
__device__ __forceinline__ void xcd_barrier_complete(unsigned* bar, unsigned x, unsigned& nloc, unsigned& nx) {
    const unsigned G = gridDim.x * gridDim.y * gridDim.z;
    unsigned sum, cnt, mine, sp = 0u;
    for (;;) {
        sum = 0u; cnt = 0u; mine = 0u;
#pragma unroll
        for (unsigned j = 0; j < 16; ++j) { const unsigned c = xb_ld(&bar[XB_XCNT(j)]); sum += c; cnt += (c > 0u) ? 1u : 0u; mine = (j == x) ? c : mine; }
        if (sum == G) break;
        __builtin_amdgcn_s_sleep(1);
        if ((++sp & 255u) == 0u) { if (xb_ld(&bar[XB_TMO])) break; if (sp > XB_SPIN_CAP) { atomicAdd(&bar[XB_TMO], 1u); break; } }
    }
    nloc = mine > 0u ? mine : 1u; nx = cnt > 0u ? cnt : 1u;
}
__device__ __forceinline__ void xcd_barrier(const XcdBarrier& b) {
    asm volatile("s_waitcnt vmcnt(0)" ::: "memory");
    __syncthreads();
    if (threadIdx.x == 0) {
        unsigned* bar = b.bar;
        __builtin_amdgcn_s_waitcnt(0);
        unsigned nloc = b.st[0], nx = b.st[1];
        if (nloc == 0u) { xcd_barrier_complete(bar, b.x, nloc, nx); b.st[0] = nloc; b.st[1] = nx; }
        const unsigned old = xb_add(&bar[XB_XSUB(b.x)], 1u);
        const unsigned gen = old / nloc;
        if (old + 1u == (gen + 1u) * nloc) {
            __builtin_amdgcn_fence(__ATOMIC_RELEASE, "agent");
            asm volatile("s_waitcnt vmcnt(0)" ::: "memory");
            const unsigned og = xb_add(&bar[XB_TOP], 1u);
            const unsigned tg = og / nx;
            if (og + 1u == (tg + 1u) * nx) xb_add(&bar[XB_TOPGEN], 1u);
            else XB_SPIN(xb_ld(&bar[XB_TOPGEN]) == tg, bar);
            __builtin_amdgcn_fence(__ATOMIC_ACQUIRE, "agent");
            xb_add(&bar[XB_XGEN(b.x)], 1u);
            asm volatile("s_waitcnt vmcnt(0)" ::: "memory");
        } else {
            XB_SPIN(xb_ld(&bar[XB_XGEN(b.x)]) == gen, bar);
            __builtin_amdgcn_fence(__ATOMIC_ACQUIRE, "agent");
            asm volatile("s_waitcnt vmcnt(0)" ::: "memory");
        }
    }
    __syncthreads();
}

namespace pg8 {
constexpr int BM = 256, BK = 64, HALF = 128, HTB = HALF * BK * 2, STAGE_BYTES = 8 * HTB;
__host__ __device__ __forceinline__ int lds_byte(int r, int c) { const int st = (r >> 4) * 2 + (c >> 5), rr = r & 15, cc = c & 31, ob = rr * 64 + cc * 2; return st * 1024 + (ob ^ (((ob >> 9) & 1) << 5)); }
__host__ __device__ __forceinline__ void stage_rc(int b, int& R, int& C) { const int st = b / 1024, sb = b % 1024, swz = sb ^ (((sb >> 9) & 1) << 5); R = (st >> 1) * 16 + swz / 64; C = (st & 1) * 32 + (swz % 64) / 2; }
__host__ __device__ __forceinline__ int perm32(int rho) { const int n = rho >> 4, i = rho & 15; return 8 * (i >> 2) + 4 * n + (i & 3); }

struct Unit { const char* a; const char* b0; const char* b1; const i32x4* glst; int pm, pn, aux; };
struct Gemm { int lda2, ldb2, nt, ksw; };

template <class Epi, class Sched, bool ALIGN_EPI>
__device__ __forceinline__ void gemm_phase(LAS unsigned char* lds, const Gemm g, const Sched& S, const Epi& E) {
    const int tid = fresh_tid(), wid = __builtin_amdgcn_readfirstlane(tid >> 6), lane = tid & 63, wr = wid >> 2, wc = wid & 3, fr = lane & 15, fq = lane >> 4;
    const int nt = g.nt;
    int Ra[2]; unsigned Ca[2], voffB[2];
#pragma unroll
    for (int i = 0; i < 2; ++i) { int R, C; stage_rc(tid * 16 + i * 8192, R, C); const int Rb = Epi::PERM ? ((R & ~31) + perm32(R & 31)) : R;
        Ra[i] = R; Ca[i] = (unsigned)C * 2u; voffB[i] = (unsigned)Rb * (unsigned)g.ldb2 + (unsigned)C * 2u; }
    const size_t kstep = (size_t)(BK * 2);
    const size_t hstepB = (size_t)HALF * g.ldb2;
    const unsigned ldsw = (unsigned)wid * 1024u;
    const int aoff = lds_byte(wr * 64 + fr, fq * 8), boff = lds_byte(wc * 32 + fr, fq * 8);
#define PG8_SA(b, h) (((b) * 2 + (h)) * HTB)
#define PG8_SB(b, h) ((4 + (b) * 2 + (h)) * HTB)
#define PG8_STAGE(bufoff, gbase, voff) do { _Pragma("unroll") for (int _i = 0; _i < 2; ++_i) \
        __builtin_amdgcn_global_load_lds((const unsigned*)((const char*)(gbase) + (voff)[_i]), (LAS unsigned*)(lds + (bufoff) + ldsw + _i * 8192), 16, 0, 0); } while (0)
#define PG8_STAGE2(bufoff, gbase, v0, v1) do { \
        __builtin_amdgcn_global_load_lds((const unsigned*)((const char*)(gbase) + (v0)), (LAS unsigned*)(lds + (bufoff) + ldsw), 16, 0, 0); \
        __builtin_amdgcn_global_load_lds((const unsigned*)((const char*)(gbase) + (v1)), (LAS unsigned*)(lds + (bufoff) + ldsw + 8192), 16, 0, 0); } while (0)
#define PG8_LDA(dst, b, h) do { _Pragma("unroll") for (int m = 0; m < 4; ++m) _Pragma("unroll") for (int k = 0; k < 2; ++k) dst[m][k] = *(const LAS bf16x8*)(lds + PG8_SA(b, h) + aoff + m * 2048 + k * 1024); } while (0)
#define PG8_LDB(dst, b, h) do { _Pragma("unroll") for (int n = 0; n < 2; ++n) _Pragma("unroll") for (int k = 0; k < 2; ++k) dst[n][k] = *(const LAS bf16x8*)(lds + PG8_SB(b, h) + boff + n * 2048 + k * 1024); } while (0)
#define PG8_MMA(ai, bj, At, Bt) do { __builtin_amdgcn_s_setprio(1); _Pragma("unroll") for (int m = 0; m < 4; ++m) _Pragma("unroll") for (int n = 0; n < 2; ++n) _Pragma("unroll") for (int k = 0; k < 2; ++k) \
        acc[ai][bj][m][n] = __builtin_amdgcn_mfma_f32_16x16x32_bf16(Bt[n][k], At[m][k], acc[ai][bj][m][n], 0, 0, 0); __builtin_amdgcn_s_setprio(0); } while (0)
#define PG8_WAIT_V(n) asm volatile("s_waitcnt vmcnt(" #n ")" ::: "memory")
#define PG8_WAIT_L(n) asm volatile("s_waitcnt lgkmcnt(" #n ")" ::: "memory")
#define PG8_BAR __builtin_amdgcn_s_barrier()
#define PG8_SCHED __builtin_amdgcn_sched_barrier(0)
    const size_t hstepA = (size_t)HALF * g.lda2;
    unsigned voffA[2];
#pragma unroll
    for (int i = 0; i < 2; ++i) voffA[i] = (unsigned)Ra[i] * (unsigned)g.lda2 + Ca[i];
#define PG8_AROWS(u, v) do { if constexpr (Sched::GATHER) { _Pragma("unroll") for (int _h = 0; _h < 2; ++_h) { const int _r0 = _h * HALF + Ra[0], _r1 = _h * HALF + Ra[1]; \
        const int _e0 = (u).glst[_r0].x, _e1 = (u).glst[_r1].x; v[_h] = (unsigned)((_r0 < (u).aux) ? _e0 : 0) | ((unsigned)((_r1 < (u).aux) ? _e1 : 0) << 16); } \
        asm volatile("" : "+v"(v[0]), "+v"(v[1])); } } while (0)
#define PG8_STAGE_A(bufoff, gbase, v, h) do { if constexpr (Sched::GATHER) { \
        __builtin_amdgcn_global_load_lds((const unsigned*)((const char*)(gbase) + (((v)[h] & 0xffffu) * (unsigned)g.lda2 + Ca[0])), (LAS unsigned*)(lds + (bufoff) + ldsw), 16, 0, 0); \
        __builtin_amdgcn_global_load_lds((const unsigned*)((const char*)(gbase) + (((v)[h] >> 16) * (unsigned)g.lda2 + Ca[1])), (LAS unsigned*)(lds + (bufoff) + ldsw + 8192), 16, 0, 0); } \
      else { PG8_STAGE(bufoff, (const char*)(gbase) + (h) * hstepA, voffA); } } while (0)
    Unit cur, nxt; int ui = 0;
    if (!S.next(0, cur)) return;
    f32x4 acc[2][2][4][2];
#pragma unroll
    for (int a = 0; a < 2; ++a)
#pragma unroll
        for (int b = 0; b < 2; ++b)
#pragma unroll
            for (int m = 0; m < 4; ++m)
#pragma unroll
                for (int n = 0; n < 2; ++n) acc[a][b][m][n] = (f32x4){0.f, 0.f, 0.f, 0.f};
    bf16x8 At[4][2], B0[2][2], B1[2][2];
    unsigned vA[2] = {0u, 0u}, vN[2] = {0u, 0u};
    PG8_AROWS(cur, vA);
    const char* cA = cur.a; const char* cB0 = cur.b0; const char* cB1 = cur.b1;
    PG8_STAGE(PG8_SB(0, 0), cB0, voffB); PG8_STAGE(PG8_SB(0, 1), cB0 + hstepB, voffB); PG8_STAGE_A(PG8_SA(0, 0), cA, vA, 0); PG8_STAGE_A(PG8_SA(0, 1), cA, vA, 1);
    if (wr == 1) PG8_BAR;
    PG8_WAIT_V(2); PG8_BAR;
    PG8_STAGE(PG8_SB(1, 0), cB0 + kstep, voffB); PG8_STAGE_A(PG8_SA(1, 0), cA + kstep, vA, 0); PG8_STAGE(PG8_SB(1, 1), cB0 + hstepB + kstep, voffB);
    PG8_WAIT_V(6); PG8_BAR;
    for (;;) {
        const bool has_next = S.next(ui + 1, nxt);
        if (has_next) { PG8_AROWS(nxt, vN); } else { vN[0] = vA[0]; vN[1] = vA[1]; }
        const char* nA = has_next ? nxt.a : cA; const char* nB = has_next ? nxt.b0 : cB0;
        for (int t = 0; t < nt; t += 2) {
            const bool last = (t == nt - 2);
            const char* a1 = cA + (size_t)(t + 1) * kstep;
            const char* a2 = last ? nA : cA + (size_t)(t + 2) * kstep;
            const char* b2 = last ? nB : ((t + 2 < g.ksw) ? cB0 + (size_t)(t + 2) * kstep : cB1 + (size_t)(t + 2 - g.ksw) * kstep);
            const char* a3 = a2 + kstep; const char* b3 = b2 + kstep;
            unsigned vS[2]; vS[0] = last ? vN[0] : vA[0]; vS[1] = last ? vN[1] : vA[1];
            PG8_LDB(B0, 0, 0); PG8_LDB(B1, 0, 1); PG8_SCHED; PG8_LDA(At, 0, 0); PG8_STAGE_A(PG8_SA(1, 1), a1, vA, 1);
            PG8_WAIT_V(8); PG8_WAIT_L(0); PG8_BAR; PG8_MMA(0, 0, At, B0); PG8_MMA(0, 1, At, B1); PG8_BAR; PG8_SCHED;
            PG8_LDA(At, 0, 1); PG8_STAGE(PG8_SB(0, 0), b2, voffB); PG8_STAGE(PG8_SB(0, 1), b2 + hstepB, voffB); PG8_STAGE_A(PG8_SA(0, 0), a2, vS, 0);
            PG8_WAIT_V(8); PG8_WAIT_L(0); PG8_BAR; PG8_MMA(1, 0, At, B0); PG8_MMA(1, 1, At, B1); PG8_BAR; PG8_SCHED;
            PG8_LDB(B0, 1, 0); PG8_LDB(B1, 1, 1); PG8_SCHED; PG8_LDA(At, 1, 0); PG8_STAGE_A(PG8_SA(0, 1), a2, vS, 1);
            PG8_WAIT_V(8); PG8_WAIT_L(0); PG8_BAR; PG8_MMA(0, 0, At, B0); PG8_MMA(0, 1, At, B1); PG8_BAR; PG8_SCHED;
            PG8_LDA(At, 1, 1); PG8_STAGE(PG8_SB(1, 0), b3, voffB); PG8_STAGE(PG8_SB(1, 1), b3 + hstepB, voffB); PG8_STAGE_A(PG8_SA(1, 0), a3, vS, 0);
            PG8_WAIT_V(8); PG8_WAIT_L(0); PG8_BAR; PG8_MMA(1, 0, At, B0); PG8_MMA(1, 1, At, B1); PG8_BAR; PG8_SCHED;
        }
        if constexpr (ALIGN_EPI) { if (wr == 0) PG8_BAR; }
        { int t_e = threadIdx.x; asm volatile("" : "+v"(t_e)); const int fr_e = t_e & 15, fq_e = (t_e >> 4) & 3;
          E(acc, cur, wr, wc, fr_e, fq_e); }
        if (!has_next) break;
#pragma unroll
        for (int a = 0; a < 2; ++a)
#pragma unroll
            for (int b = 0; b < 2; ++b)
#pragma unroll
                for (int m = 0; m < 4; ++m)
#pragma unroll
                    for (int n = 0; n < 2; ++n) acc[a][b][m][n] = (f32x4){0.f, 0.f, 0.f, 0.f};
        cur = nxt; cA = nA; cB0 = nxt.b0; cB1 = nxt.b1; ++ui;
        vA[0] = vN[0]; vA[1] = vN[1];
        if constexpr (ALIGN_EPI) { if (wr == 1) PG8_BAR; }
    }
    PG8_WAIT_V(0);
    if constexpr (!ALIGN_EPI) { if (wr == 0) PG8_BAR; }
    PG8_BAR;
#undef PG8_SA
#undef PG8_SB
#undef PG8_STAGE
#undef PG8_STAGE2
#undef PG8_LDA
#undef PG8_LDB
#undef PG8_MMA
#undef PG8_WAIT_V
#undef PG8_WAIT_L
#undef PG8_BAR
#undef PG8_SCHED
#undef PG8_AROWS
#undef PG8_STAGE_A
}
}
struct Frame {
    LAS unsigned char* lds;
    volatile LAS unsigned* MISC;
    gu32* ctl;
    int vcu, G;
    const float* in[29];
    float* out;
    unsigned char* ws;
};
enum { I_X = 0, I_C, I_CTX, I_CCTX, I_WMOD, I_BMOD, I_N1G, I_N2G, I_POOLW, I_POOLB, I_POOLLS, I_WQKV, I_QG, I_KG, I_WO, I_WIN, I_BIN, I_LNG, I_LNB, I_WS, I_BS, I_WOUT,
       I_WRG, I_BRG, I_WRE, I_BRE, I_WG, I_WU, I_WD };
__device__ __forceinline__ const float* modvec(const Frame& F, int layer, int row) {
    const int j = row < NLAT ? (row >> 12) : 8; return (const float*)(F.ws + WS_MOD) + (size_t)(layer * 9 + j) * 6144; }
__device__ __forceinline__ float* xrow(const Frame& F, int row) { return row < NLAT ? F.out + (size_t)row * D : (float*)(F.ws + WS_XC) + (size_t)(row - NLAT) * D; }

struct DenseSched {
    static constexpr bool GATHER = false;
    const char* A; const char* B; int nN, nunits, vcu, G; size_t a_tile, b_tile; int a_coloff, pm0;
    __device__ __forceinline__ bool next(int i, pg8::Unit& u) const {
        const int L = vcu + i * G; if (L >= nunits) return false;
        const int pm = L / nN + pm0, pn = L % nN;
        u.a = A + (size_t)pm * a_tile + (size_t)pn * a_coloff; u.b0 = B + (size_t)pn * b_tile; u.b1 = u.b0; u.glst = nullptr; u.pm = pm; u.pn = pn; u.aux = 256; return true;
    }
};
struct QkvSched {
    static constexpr bool GATHER = false;
    const char* A; const char* B; int vcu, G;
    __device__ __forceinline__ bool next(int i, pg8::Unit& u) const {
        const int L = vcu + i * G; int pm, pn;
        if (L < 128 * 6) { pm = L / 6; pn = L % 6; } else if (L < 128 * 6 + 16) { const int r = L - 768; pm = 128 + (r >> 1); pn = 4 + (r & 1); } else return false;
        u.a = A + (size_t)pm * (256 * 2048); u.b0 = B + (size_t)pn * (256 * 2048); u.b1 = u.b0; u.glst = nullptr; u.pm = pm; u.pn = pn; u.aux = 256; return true;
    }
};
struct MoeSched {
    static constexpr bool GATHER_DUMMY = false;
    const volatile LAS int* tab; int vcu, G, ntile;
    __device__ __forceinline__ bool find(int i, int& tile, int& pn, int& b, int& tin, int& valid) const {
        const int L = vcu + i * G; if (L >= ntile * 4) return false;
        tile = L >> 2; pn = L & 3; b = 0;
        for (int k = 1; k < 24; ++k) b += (tab[k] <= tile) ? 1 : 0;
        b = __builtin_amdgcn_readfirstlane(b);
        tin = tile - __builtin_amdgcn_readfirstlane(tab[b]); const int c = __builtin_amdgcn_readfirstlane(tab[32 + b]) - tin * 256; valid = c < 256 ? c : 256; return true;
    }
};
__device__ __forceinline__ void bucket_experts(int b, int& elo, int& ehi) { const int gs = b / 6, p = b % 6; const int lo = p < 3 ? 0 : (p < 5 ? 1 : 2), hi = p < 3 ? p + 1 : (p < 5 ? p - 1 : 3); elo = gs * 4 + lo; ehi = gs * 4 + hi; }
struct Moe1Sched {
    static constexpr bool GATHER = true;
    MoeSched m; const char* H2; const char* Wgu; const i32x4* list;
    __device__ __forceinline__ bool next(int i, pg8::Unit& u) const {
        int tile, pn, b, tin, valid; if (!m.find(i, tile, pn, b, tin, valid)) return false;
        int elo, ehi; bucket_experts(b, elo, ehi); const int e = pn < 2 ? elo : ehi;
        u.a = H2; u.b0 = Wgu + ((size_t)e * 512 + (size_t)(pn & 1) * 256) * 2048; u.b1 = u.b0; u.glst = list + (size_t)b * LIST_CAP + tin * 256; u.pm = tile; u.pn = pn; u.aux = valid; return true;
    }
};
struct Moe2Sched {
    static constexpr bool GATHER = false;
    MoeSched m; const char* HID; const char* Wd; const i32x4* list;
    __device__ __forceinline__ bool next(int i, pg8::Unit& u) const {
        int tile, pn, b, tin, valid; if (!m.find(i, tile, pn, b, tin, valid)) return false;
        int elo, ehi; bucket_experts(b, elo, ehi);
        u.a = HID + (size_t)tile * (256 * 1024); u.b0 = Wd + ((size_t)elo * 1024 + (size_t)pn * 256) * 512; u.b1 = Wd + ((size_t)ehi * 1024 + (size_t)pn * 256) * 512;
        u.glst = list + (size_t)b * LIST_CAP + tin * 256; u.pm = tile; u.pn = pn; u.aux = valid; return true;
    }
};

using pg8::Unit;
struct EpiResid {
    static constexpr bool PERM = false;
    Frame* F; int layer; const float* bias; const float* mul; const float* xin_lat; const float* xin_ctx;
    __device__ __forceinline__ void operator()(const f32x4 (&acc)[2][2][4][2], const Unit& u, int wr, int wc, int fr, int fq) const {
        const int row0 = u.pm * 256; const bool lat = row0 < NLAT;
        const float* gate = modvec(*F, layer, row0) + 2 * 1024;
        const float* xin = lat ? xin_lat + (size_t)row0 * D : xin_ctx + (size_t)(row0 - NLAT) * D;
        float* xo = xrow(*F, row0);
        const int col0 = u.pn * 256 + wc * 32 + 4 * fq;
#pragma unroll
        for (int bj = 0; bj < 2; ++bj)
#pragma unroll
            for (int n = 0; n < 2; ++n) { const int c = col0 + bj * 128 + n * 16;
                const f32x4 gv = *(const f32x4*)(gate + c);
                f32x4 bv = (f32x4){0.f, 0.f, 0.f, 0.f}, mv = (f32x4){1.f, 1.f, 1.f, 1.f};
                if (bias) { bv = *(const f32x4*)(bias + c); mv = *(const f32x4*)(mul + c); }
#pragma unroll
                for (int ai = 0; ai < 2; ++ai) {
#pragma unroll
                    for (int m = 0; m < 4; ++m) { const size_t off = (size_t)(ai * 128 + wr * 64 + m * 16 + fr) * D + c;
                        const f32x4 xv = *(const f32x4*)(xin + off);
                        *(f32x4*)(xo + off) = xv + gv * ((acc[ai][bj][m][n] + bv) * mv); }
                    asm volatile("" ::: "memory"); } }
    }
};
struct EpiQkv {
    static constexpr bool PERM = false;
    Frame* F; const float* qg; const float* kg;
    __device__ __forceinline__ void operator()(const f32x4 (&acc)[2][2][4][2], const Unit& u, int wr, int wc, int fr, int fq) const {
        const int row0 = u.pm * 256; const bool lat = row0 < NLAT; const int pn = u.pn;
        bf16_t* Q = (bf16_t*)(F->ws + WS_Q); bf16_t* K = (bf16_t*)(F->ws + WS_K); bf16_t* V = (bf16_t*)(F->ws + WS_V);
        if (pn == 5) {
#pragma unroll
            for (int ai = 0; ai < 2; ++ai)
#pragma unroll
                for (int m = 0; m < 4; ++m) { const int row = row0 + ai * 128 + wr * 64 + m * 16 + fr;
                    const size_t kvrow = lat ? (size_t)(row >> 12) * KVROWS + CTXL + (row & 4095) : (size_t)((row - NLAT) >> 8) * KVROWS + ((row - NLAT) & 255);
#pragma unroll
                    for (int bj = 0; bj < 2; ++bj)
#pragma unroll
                        for (int n = 0; n < 2; ++n) { const f32x4 v = acc[ai][bj][m][n]; u32x2 w; w.x = cvt_pk_bf16(v[0], v[1]); w.y = cvt_pk_bf16(v[2], v[3]);
                            *(u32x2*)(V + kvrow * KVP + bj * 128 + wc * 32 + n * 16 + 4 * fq) = w; } }
            return;
        }
        const bool isq = pn < 4; const float* gsrc = isq ? qg : kg;
        f32x4 gv[2][2];
#pragma unroll
        for (int bj = 0; bj < 2; ++bj)
#pragma unroll
            for (int n = 0; n < 2; ++n) gv[bj][n] = *(const f32x4*)(gsrc + 32 * bj + 16 * n + 4 * fq);
        const float qs = isq ? 0.125f * 1.4426950408889634f : 1.0f;
        const float* COS = (const float*)(F->ws + WS_COS); const float* SIN = (const float*)(F->ws + WS_SIN);
#pragma unroll
        for (int ai = 0; ai < 2; ++ai)
#pragma unroll
            for (int m = 0; m < 4; ++m) { const int row = row0 + ai * 128 + wr * 64 + m * 16 + fr;
                float ss = 0.f;
#pragma unroll
                for (int bj = 0; bj < 2; ++bj)
#pragma unroll
                    for (int n = 0; n < 2; ++n) { const f32x4 v = acc[ai][bj][m][n]; ss += (v[0] * v[0] + v[1] * v[1]) + (v[2] * v[2] + v[3] * v[3]); }
                ss += __shfl_xor(ss, 16); ss += __shfl_xor(ss, 32);
                const float rstd = 1.0f / sqrtf(ss * (1.0f / 64.0f) + EPS);
                bf16_t* dst;
                if (isq) dst = Q + (size_t)row * D + (pn * 4 + wc) * 64;
                else { const size_t kvrow = lat ? (size_t)(row >> 12) * KVROWS + CTXL + (row & 4095) : (size_t)((row - NLAT) >> 8) * KVROWS + ((row - NLAT) & 255); dst = K + kvrow * KVP + wc * 64; }
                const int t = row & 4095;
#pragma unroll
                for (int bj = 0; bj < 2; ++bj) {
                    f32x4 x1 = acc[ai][bj][m][0] * rstd * gv[bj][0], x2 = acc[ai][bj][m][1] * rstd * gv[bj][1];
                    if (lat) { const int pos = bj == 0 ? (t >> 6) : (t & 63);
                        const f32x4 c = *(const f32x4*)(COS + pos * 16 + 4 * fq), s = *(const f32x4*)(SIN + pos * 16 + 4 * fq);
                        const f32x4 o1 = x1 * c - x2 * s, o2 = x2 * c + x1 * s; x1 = o1; x2 = o2; }
                    x1 = x1 * qs; x2 = x2 * qs;
                    u32x2 w1, w2; w1.x = cvt_pk_bf16(x1[0], x1[1]); w1.y = cvt_pk_bf16(x1[2], x1[3]); w2.x = cvt_pk_bf16(x2[0], x2[1]); w2.y = cvt_pk_bf16(x2[2], x2[3]);
                    *(u32x2*)(dst + 32 * bj + 4 * fq) = w1; *(u32x2*)(dst + 32 * bj + 16 + 4 * fq) = w2; } }
    }
};
struct EpiSgu1 {
    static constexpr bool PERM = true;
    Frame* F; const float* bin;
    __device__ __forceinline__ void operator()(const f32x4 (&acc)[2][2][4][2], const Unit& u, int wr, int wc, int fr, int fq) const {
        bf16_t* O = (bf16_t*)(F->ws + (u.pn < 4 ? WS_U : WS_VS)); const int ct = (u.pn & 3) * 256;
        const int col0 = wc * 32 + 8 * fq;
#pragma unroll
        for (int bj = 0; bj < 2; ++bj) {
            const f32x4 b0 = *(const f32x4*)(bin + u.pn * 256 + col0 + bj * 128), b1 = *(const f32x4*)(bin + u.pn * 256 + col0 + bj * 128 + 4);
#pragma unroll
            for (int ai = 0; ai < 2; ++ai)
#pragma unroll
                for (int m = 0; m < 4; ++m) { const int row = u.pm * 256 + ai * 128 + wr * 64 + m * 16 + fr;
                    f32x4 v0 = acc[ai][bj][m][0] + b0, v1 = acc[ai][bj][m][1] + b1; float o[8];
#pragma unroll
                    for (int e = 0; e < 8; ++e) { const float v = e < 4 ? v0[e] : v1[e - 4]; const float t = 1.5957691216057308f * (v + 0.044715f * v * v * v);
                        o[e] = v * __builtin_amdgcn_rcpf(1.0f + __builtin_amdgcn_exp2f(-1.4426950408889634f * t)); }
                    u32x4 w; w.x = cvt_pk_bf16(o[0], o[1]); w.y = cvt_pk_bf16(o[2], o[3]); w.z = cvt_pk_bf16(o[4], o[5]); w.w = cvt_pk_bf16(o[6], o[7]);
                    *(u32x4*)(O + (size_t)row * D + ct + col0 + bj * 128) = w; } }
    }
};
struct EpiMoe1 {
    static constexpr bool PERM = true;
    Frame* F;
    __device__ __forceinline__ void operator()(const f32x4 (&acc)[2][2][4][2], const Unit& u, int wr, int wc, int fr, int fq) const {
        bf16_t* HID = (bf16_t*)(F->ws + WS_HID); const int col0 = (u.pn >> 1) * 256 + (u.pn & 1) * 128 + wc * 32 + 8 * fq;
#pragma unroll
        for (int ai = 0; ai < 2; ++ai)
#pragma unroll
            for (int m = 0; m < 4; ++m) { const int rr = ai * 128 + wr * 64 + m * 16 + fr;
                const i32x4 e = u.glst[rr]; const float w = (rr < u.aux) ? __int_as_float((u.pn >> 1) ? e.z : e.y) : 0.f;
                float o[8];
#pragma unroll
                for (int k = 0; k < 8; ++k) { const float gt = k < 4 ? acc[ai][0][m][0][k] : acc[ai][0][m][1][k - 4], up = k < 4 ? acc[ai][1][m][0][k] : acc[ai][1][m][1][k - 4];
                    o[k] = gt * __builtin_amdgcn_rcpf(1.0f + __builtin_amdgcn_exp2f(-1.4426950408889634f * gt)) * up * w; }
                u32x4 pk; pk.x = cvt_pk_bf16(o[0], o[1]); pk.y = cvt_pk_bf16(o[2], o[3]); pk.z = cvt_pk_bf16(o[4], o[5]); pk.w = cvt_pk_bf16(o[6], o[7]);
                *(u32x4*)(HID + ((size_t)u.pm * 256 + rr) * 512 + col0) = pk; asm volatile("" ::: "memory"); }
    }
};
struct EpiMoe2 {
    static constexpr bool PERM = false;
    Frame* F; int layer;
    __device__ __forceinline__ void operator()(const f32x4 (&acc)[2][2][4][2], const Unit& u, int wr, int wc, int fr, int fq) const {
        const int col0 = u.pn * 256 + wc * 32 + 4 * fq;
#pragma unroll
        for (int ai = 0; ai < 2; ++ai)
#pragma unroll
            for (int m = 0; m < 4; ++m) { const int rr = ai * 128 + wr * 64 + m * 16 + fr;
                if (rr < u.aux) { const int row = u.glst[rr].x; const float* gate = modvec(*F, layer, row) + 5 * 1024; float* xo = xrow(*F, row);
#pragma unroll
                    for (int bj = 0; bj < 2; ++bj)
#pragma unroll
                        for (int n = 0; n < 2; ++n) { const int c = col0 + bj * 128 + n * 16; const f32x4 gv = *(const f32x4*)(gate + c);
                            *(f32x4*)(xo + c) = *(const f32x4*)(xo + c) + gv * acc[ai][bj][m][n]; } }
                asm volatile("" ::: "memory"); }
    }
};

template <class RM> __device__ __forceinline__ void transpose_item(const float* W, int ldw, bf16_t* WT, int ldt, int k0, int n0, LAS float* scr, int lane, RM rm) {
#pragma unroll 8
    for (int i = 0; i < 32; ++i) { const int kk = 2 * i + (lane >> 5); scr[kk * 33 + (lane & 31)] = W[(size_t)(k0 + kk) * ldw + n0 + (lane & 31)]; }
    LDS_WAIT(); asm volatile("" ::: "memory");
    const int c = lane & 7;
#pragma unroll
    for (int j = 0; j < 4; ++j) { const int n = (lane >> 3) + 8 * j; const LAS float* s = scr + (8 * c) * 33 + n;
        u32x4 o; o.x = cvt_pk_bf16(s[0 * 33], s[1 * 33]); o.y = cvt_pk_bf16(s[2 * 33], s[3 * 33]); o.z = cvt_pk_bf16(s[4 * 33], s[5 * 33]); o.w = cvt_pk_bf16(s[6 * 33], s[7 * 33]);
        *(GAS u32x4*)(WT + (size_t)rm(n0 + n) * ldt + k0 + 8 * c) = o; }
    LDS_WAIT(); asm volatile("" ::: "memory");
}
struct RmId { __device__ __forceinline__ int operator()(int n) const { return n; } };
struct RmQkv { __device__ __forceinline__ int operator()(int n) const { const int t = n >> 8, lc = n & 255; return t < 5 ? t * 256 + 128 * ((lc >> 5) & 1) + 32 * (lc >> 6) + (lc & 31) : n; } };
struct RmGu { int up; __device__ __forceinline__ int operator()(int f) const { return (f >> 7) * 256 + up * 128 + (f & 127); } };

__device__ __forceinline__ void p0_prologue(Frame& F) {
    const int tid = fresh_tid(), lane = tid & 63, wave = __builtin_amdgcn_readfirstlane(tid >> 6);
    {
        LAS float* sl = (LAS float*)F.lds; LAS float* part = (LAS float*)(F.lds + 40960);
        for (int idx = tid; idx < 9 * 1024; idx += NTHR) { const int j = idx >> 10, k = idx & 1023; const float v = j < 8 ? F.in[I_C][j * 1024 + k] : F.in[I_CCTX][k]; sl[idx] = v / (1.0f + expf(-v)); }
        __syncthreads();
        for (int u = F.vcu; u < 384; u += F.G) {
            const int l = u / 96, cb = u % 96, col = cb * 64 + lane;
            const float* w = F.in[I_WMOD] + ((size_t)l * 1024 + wave * 128) * 6144 + col;
            float acc[9];
#pragma unroll
            for (int j = 0; j < 9; ++j) acc[j] = 0.f;
#pragma unroll 8
            for (int kk = 0; kk < 128; ++kk) { const float wv = w[(size_t)kk * 6144];
#pragma unroll
                for (int j = 0; j < 9; ++j) acc[j] += sl[j * 1024 + wave * 128 + kk] * wv; }
#pragma unroll
            for (int j = 0; j < 9; ++j) part[(wave * 9 + j) * 64 + lane] = acc[j];
            __syncthreads();
            for (int idx = tid; idx < 576; idx += NTHR) { const int j = idx >> 6, ln = idx & 63; float s = 0.f;
#pragma unroll
                for (int w8 = 0; w8 < 8; ++w8) s += part[(w8 * 9 + j) * 64 + ln];
                const int c6 = cb * 64 + ln; s += F.in[I_BMOD][l * 6144 + c6];
                const int which = c6 >> 10, d = c6 & 1023;
                if (which == 1) s = F.in[I_N1G][l * 1024 + d] * (1.0f + s);
                if (which == 4) s = F.in[I_N2G][l * 1024 + d] * (1.0f + s);
                ((float*)(F.ws + WS_MOD))[(size_t)(l * 9 + j) * 6144 + c6] = s; }
            __syncthreads();
        }
    }
    if (blockIdx.x == 1) { for (int idx = tid; idx < 1024; idx += NTHR) { const int pos = idx >> 4, i = idx & 15; const float ang = (float)pos * powf(10000.f, -(float)i / 16.f);
            ((float*)(F.ws + WS_COS))[idx] = cosf(ang); ((float*)(F.ws + WS_SIN))[idx] = sinf(ang); } }
    LAS float* scr = (LAS float*)(F.lds + wave * 8704);
    const int gw = F.vcu * NWAVES + wave, NGW = F.G * NWAVES;
    constexpr int S0 = 768, S1 = S0 + 512, S2 = S1 + 1024, S3 = S2 + 512, S4 = S3 + 256, S5 = S4 + 8192, S6 = S5 + 8192, S7 = S6 + 8192, S8 = S7 + 256;
    for (int it = gw; it < S8; it += NGW) {
        if (it < S0) { const int kb = it / 48, nb = it % 48; transpose_item(F.in[I_WQKV], 1536, (bf16_t*)(F.ws + WS_WQKV), 1024, kb * 64, nb * 32, scr, lane, RmQkv()); }
        else if (it < S1) { const int r = it - S0, kb = r / 32, nb = r % 32; transpose_item(F.in[I_WO], 1024, (bf16_t*)(F.ws + WS_WO), 1024, kb * 64, nb * 32, scr, lane, RmId()); }
        else if (it < S2) { const int r = it - S1, kb = r / 64, nb = r % 64; transpose_item(F.in[I_WIN], 2048, (bf16_t*)(F.ws + WS_WIN), 1024, kb * 64, nb * 32, scr, lane, RmId()); }
        else if (it < S3) { const int r = it - S2, kb = r / 32, nb = r % 32; transpose_item(F.in[I_WOUT], 1024, (bf16_t*)(F.ws + WS_WOUT), 1024, kb * 64, nb * 32, scr, lane, RmId()); }
        else if (it < S4) { const int r = it - S3, mat = r >> 5, q = r & 31, kb = q >> 3, nb = q & 7; transpose_item(F.in[I_POOLW] + (size_t)mat * 65536, 256, (bf16_t*)(F.ws + WS_WPOOL) + (size_t)mat * 65536, 256, kb * 64, nb * 32, scr, lane, RmId()); }
        else if (it < S5) { const int r = it - S4, mat = r >> 7, q = r & 127, kb = q >> 3, nb = q & 7; RmGu rm; rm.up = 0;
            transpose_item(F.in[I_WG] + (size_t)mat * 262144, 256, (bf16_t*)(F.ws + WS_WGU) + (size_t)mat * 524288, 1024, kb * 64, nb * 32, scr, lane, rm); }
        else if (it < S6) { const int r = it - S5, mat = r >> 7, q = r & 127, kb = q >> 3, nb = q & 7; RmGu rm; rm.up = 1;
            transpose_item(F.in[I_WU] + (size_t)mat * 262144, 256, (bf16_t*)(F.ws + WS_WGU) + (size_t)mat * 524288, 1024, kb * 64, nb * 32, scr, lane, rm); }
        else if (it < S7) { const int r = it - S6, mat = r >> 7, q = r & 127, kb = q >> 5, nb = q & 31;
            transpose_item(F.in[I_WD] + (size_t)mat * 262144, 1024, (bf16_t*)(F.ws + WS_WD) + (size_t)mat * 262144, 256, kb * 64, nb * 32, scr, lane, RmId()); }
        else { const int r = it - S7; const f32x4* s = (const f32x4*)(F.in[I_WS] + (size_t)r * 512 + lane * 8); const f32x4 a = s[0], b = s[1];
            u32x4 o; o.x = cvt_pk_bf16(a[0], a[1]); o.y = cvt_pk_bf16(a[2], a[3]); o.z = cvt_pk_bf16(b[0], b[1]); o.w = cvt_pk_bf16(b[2], b[3]);
            *(u32x4*)((bf16_t*)(F.ws + WS_WSP) + (size_t)r * 512 + lane * 8) = o; }
    }
}

__device__ __forceinline__ void norm_phase(Frame& F, int layer, int nrows) {
    const int tid = fresh_tid(), lane = tid & 63, wave = __builtin_amdgcn_readfirstlane(tid >> 6);
    const int gw = F.vcu * NWAVES + wave, NGW = F.G * NWAVES, rpw = (nrows + NGW - 1) / NGW; bf16_t* A = (bf16_t*)(F.ws + WS_A);
    for (int r = gw * rpw; r < (gw + 1) * rpw && r < nrows; ++r) {
        const float* mv = modvec(F, layer, r); const f32x4* xr = (const f32x4*)xrow(F, r) + lane;
        f32x4 v[4]; float s = 0.f;
#pragma unroll
        for (int j = 0; j < 4; ++j) { v[j] = xr[64 * j]; s += (v[j][0] * v[j][0] + v[j][1] * v[j][1]) + (v[j][2] * v[j][2] + v[j][3] * v[j][3]); }
        const float rstd = 1.0f / sqrtf(wave_sum(s) * (1.0f / D) + EPS);
        u32x2* o = (u32x2*)(A + (size_t)r * D) + lane;
#pragma unroll
        for (int j = 0; j < 4; ++j) { const f32x4 gm = ((const f32x4*)(mv + 1024))[lane + 64 * j], sh = ((const f32x4*)mv)[lane + 64 * j]; const f32x4 y = v[j] * rstd * gm + sh;
            u32x2 w; w.x = cvt_pk_bf16(y[0], y[1]); w.y = cvt_pk_bf16(y[2], y[3]); o[64 * j] = w; }
    }
}
__device__ __forceinline__ void pool_phase(Frame& F, int layer, int ntile, const float* xlat, const float* xctx) {
    const int tid = fresh_tid(), lane = tid & 63, wave = __builtin_amdgcn_readfirstlane(tid >> 6);
    LAS float* rs = (LAS float*)F.lds; bf16_t* A = (bf16_t*)(F.ws + WS_A);
    for (int tile = F.vcu; tile < ntile; tile += F.G) {
        const int row0 = tile * 64; const bool lat = row0 < NLAT;
        const int n = lat ? SEQ : CTXL, sb = lat ? (row0 & ~(SEQ - 1)) : NLAT + ((row0 - NLAT) & ~(CTXL - 1)), t0 = row0 - sb;
        const float* xs = lat ? xlat + (size_t)sb * D : xctx + (size_t)(sb - NLAT) * D;
        const int jlo = t0 - 8 > 0 ? t0 - 8 : 0, jhi = t0 + 72 < n ? t0 + 72 : n;
        for (int j = jlo + wave; j < jhi; j += NWAVES) { const f32x4* xr = (const f32x4*)(xs + (size_t)j * D) + lane; float s = 0.f;
#pragma unroll
            for (int q = 0; q < 4; ++q) { const f32x4 v = xr[64 * q]; s += (v[0] * v[0] + v[1] * v[1]) + (v[2] * v[2] + v[3] * v[3]); }
            s = wave_sum(s); if (lane == 0) rs[j - jlo] = 1.0f / sqrtf(s * (1.0f / D) + EPS); }
        __syncthreads();
        const int c0 = 2 * tid, h = 1 << (tid >> 7);
        const f32x2 gm = *(const f32x2*)(modvec(F, layer, row0) + 1024 + c0);
        const float* xc = xs + c0;
#define XR(j) (*(const f32x2*)(xc + (size_t)(j) * D) * rs[(j) - jlo])
        f32x2 S = (f32x2){0.f, 0.f};
        { const int lo = t0 - h > 0 ? t0 - h : 0, hi = t0 + h < n ? t0 + h : n; for (int j = lo; j < hi; ++j) S += XR(j); }
        for (int t = t0; t < t0 + 64; ++t) {
            const int lo = t - h > 0 ? t - h : 0, hi = t + h < n ? t + h : n; const float inv = 1.0f / (float)(hi - lo);
            const f32x2 self = XR(t); const f32x2 p = gm * (S * inv - self);
            *(unsigned*)(A + (size_t)(sb + t) * D + c0) = cvt_pk_bf16(p[0], p[1]);
            if (t - h >= 0) S -= XR(t - h);
            if (t + h < n) S += XR(t + h);
        }
#undef XR
        __syncthreads();
    }
}
__device__ __forceinline__ void route_phase(Frame& F, int layer, int nrows) {
    constexpr int WTS = 1040;
    LAS float* WT = (LAS float*)F.lds;
    const int tid = fresh_tid(), lane = tid & 63, wave = __builtin_amdgcn_readfirstlane(tid >> 6);
    LAS float* LG = (LAS float*)(F.lds + 83200) + wave * (16 * 33);
    LAS i32x4* RES = (LAS i32x4*)(F.lds + 100352);
    LAS int* HIST = (LAS int*)(F.lds + 105472);
    const float* wrg = F.in[I_WRG] + (size_t)layer * 4096; const float* wre = F.in[I_WRE] + (size_t)layer * 16384;
    for (int idx = tid; idx < 4096; idx += NTHR) WT[(idx & 3) * WTS + (idx >> 2)] = wrg[idx];
    for (int idx = tid; idx < 16384; idx += NTHR) WT[(4 + (idx & 15)) * WTS + (idx >> 4)] = wre[idx];
    if (tid < 96) HIST[tid] = 0;
    __syncthreads();
    const int r16 = lane & 15, q = lane >> 4;
    const float* brg = F.in[I_BRG] + layer * 4; const float* bre = F.in[I_BRE] + layer * 16;
    bf16_t* H2 = (bf16_t*)(F.ws + WS_H2);
    const int ntile = nrows / 16, gw = F.vcu * NWAVES + wave, NGW = F.G * NWAVES;
    for (int tile = gw; tile < ntile; tile += NGW) {
        const int row = tile * 16 + r16; const float* mv = modvec(F, layer, tile * 16);
        const f32x4* xr = (const f32x4*)(xrow(F, tile * 16) + (size_t)r16 * D) + 2 * q;
        float ss = 0.f;
#pragma unroll 8
        for (int i = 0; i < 32; ++i) { const f32x4 a = xr[8 * i], b = xr[8 * i + 1]; ss += (a[0] * a[0] + a[1] * a[1]) + (a[2] * a[2] + a[3] * a[3]) + (b[0] * b[0] + b[1] * b[1]) + (b[2] * b[2] + b[3] * b[3]); }
        ss += __shfl_xor(ss, 16); ss += __shfl_xor(ss, 32);
        const float rstd = 1.0f / sqrtf(ss * (1.0f / D) + EPS);
        f32x4 acc0 = (f32x4){0.f, 0.f, 0.f, 0.f}, acc1 = acc0;
        const LAS f32x4* w0 = (const LAS f32x4*)(WT + r16 * WTS) + 2 * q; const LAS f32x4* w1 = (const LAS f32x4*)(WT + (16 + (r16 & 3)) * WTS) + 2 * q;
        const f32x4* gmv = (const f32x4*)(mv + 4 * 1024) + 2 * q; const f32x4* shv = (const f32x4*)(mv + 3 * 1024) + 2 * q;
        u32x4* ho = (u32x4*)(H2 + (size_t)row * D) + q;
#pragma unroll 2
        for (int i = 0; i < 32; ++i) {
            const f32x4 a = xr[8 * i] * rstd * gmv[8 * i] + shv[8 * i], b = xr[8 * i + 1] * rstd * gmv[8 * i + 1] + shv[8 * i + 1];
            u32x4 pk; pk.x = cvt_pk_bf16(a[0], a[1]); pk.y = cvt_pk_bf16(a[2], a[3]); pk.z = cvt_pk_bf16(b[0], b[1]); pk.w = cvt_pk_bf16(b[2], b[3]); ho[4 * i] = pk;
            const f32x4 p0 = w0[8 * i], p1 = w0[8 * i + 1], q0 = w1[8 * i], q1 = w1[8 * i + 1];
#pragma unroll
            for (int j = 0; j < 4; ++j) { acc0 = __builtin_amdgcn_mfma_f32_16x16x4f32(a[j], p0[j], acc0, 0, 0, 0); acc1 = __builtin_amdgcn_mfma_f32_16x16x4f32(a[j], q0[j], acc1, 0, 0, 0); }
#pragma unroll
            for (int j = 0; j < 4; ++j) { acc0 = __builtin_amdgcn_mfma_f32_16x16x4f32(b[j], p1[j], acc0, 0, 0, 0); acc1 = __builtin_amdgcn_mfma_f32_16x16x4f32(b[j], q1[j], acc1, 0, 0, 0); }
        }
#pragma unroll
        for (int rg = 0; rg < 4; ++rg) { LG[(4 * q + rg) * 33 + r16] = acc0[rg]; LG[(4 * q + rg) * 33 + 16 + r16] = acc1[rg]; }
        LDS_WAIT(); asm volatile("" ::: "memory");
        if (lane < 16) {
            const LAS float* lg = LG + lane * 33;
            const float g0 = lg[0] + brg[0], g1 = lg[1] + brg[1], g2 = lg[2] + brg[2], g3 = lg[3] + brg[3];
            int gs = 0; float gm = g0; if (g1 > gm) { gm = g1; gs = 1; } if (g2 > gm) { gm = g2; gs = 2; } if (g3 > gm) { gm = g3; gs = 3; }
            const float gwt = 1.0f / (expf(g0 - gm) + expf(g1 - gm) + expf(g2 - gm) + expf(g3 - gm));
            const float e0 = lg[4 + gs * 4] + bre[gs * 4], e1 = lg[5 + gs * 4] + bre[gs * 4 + 1], e2 = lg[6 + gs * 4] + bre[gs * 4 + 2], e3 = lg[7 + gs * 4] + bre[gs * 4 + 3];
            int i1 = 0; float v1 = e0; if (e1 > v1) { v1 = e1; i1 = 1; } if (e2 > v1) { v1 = e2; i1 = 2; } if (e3 > v1) { v1 = e3; i1 = 3; }
            int i2 = -1; float v2 = -3.0e38f;
            if (i1 != 0 && e0 > v2) { v2 = e0; i2 = 0; } if (i1 != 1 && e1 > v2) { v2 = e1; i2 = 1; } if (i1 != 2 && e2 > v2) { v2 = e2; i2 = 2; } if (i1 != 3 && e3 > v2) { v2 = e3; i2 = 3; }
            const float ex = expf(v2 - v1), wa = gwt / (1.0f + ex), wb = gwt * ex / (1.0f + ex);
            const int lo = i1 < i2 ? i1 : i2, hi = i1 < i2 ? i2 : i1; const float wlo = i1 < i2 ? wa : wb, whi = i1 < i2 ? wb : wa;
            const int bucket = gs * 6 + lo * (7 - lo) / 2 + (hi - lo - 1);
            const int slot = __hip_atomic_fetch_add(&HIST[64], 1, __ATOMIC_RELAXED, __HIP_MEMORY_SCOPE_WORKGROUP), rank = __hip_atomic_fetch_add(&HIST[bucket], 1, __ATOMIC_RELAXED, __HIP_MEMORY_SCOPE_WORKGROUP);
            RES[slot] = (i32x4){tile * 16 + lane, bucket | (rank << 5), __float_as_int(wlo), __float_as_int(whi)};
        }
        LDS_WAIT(); asm volatile("" ::: "memory");
    }
    __syncthreads();
    if (tid < 24) HIST[32 + tid] = (int)__hip_atomic_fetch_add(F.ctl + CW_CNT + 32 * layer + tid, (unsigned)HIST[tid], RLX_AGENT);
    __syncthreads();
    i32x4* LIST = (i32x4*)(F.ws + WS_LIST);
    const int nres = HIST[64];
    for (int idx = tid; idx < nres; idx += NTHR) { const i32x4 e = RES[idx]; const int b = e.y & 31, rank = e.y >> 5; LIST[(size_t)b * LIST_CAP + HIST[32 + b] + rank] = (i32x4){e.x, e.z, e.w, 0}; }
    __syncthreads();
}
__device__ __forceinline__ int moe_table(Frame& F, int layer) {
    volatile LAS int* tab = (volatile LAS int*)(F.lds + TAB_OFF);
    if (threadIdx.x == 0) { int acc = 0;
        for (int b = 0; b < 24; ++b) { const int c = (int)__hip_atomic_load(F.ctl + CW_CNT + 32 * layer + b, RLX_AGENT); tab[b] = acc; tab[32 + b] = c; acc += (c + 255) >> 8; }
        tab[24] = acc; }
    __syncthreads();
    return tab[24];
}

__device__ __forceinline__ void sgu_spatial_phase(Frame& F) {
    constexpr int BST = 144;
    LAS f32x2* ST = (LAS f32x2*)F.lds;
    LAS bf16_t* BS = (LAS bf16_t*)(F.lds + 2048);
    const bf16_t* U = (const bf16_t*)(F.ws + WS_U); const bf16_t* VS = (const bf16_t*)(F.ws + WS_VS); const bf16_t* WSP = (const bf16_t*)(F.ws + WS_WSP); bf16_t* A = (bf16_t*)(F.ws + WS_A);
    const float* lng = F.in[I_LNG]; const float* lnb = F.in[I_LNB]; const float* bs = F.in[I_BS];
    const int tid = fresh_tid(), lane = tid & 63, wave = __builtin_amdgcn_readfirstlane(tid >> 6);
    for (int chunk = F.vcu; chunk < NLAT / 128; chunk += F.G) {
        const size_t rb = (size_t)chunk * 128;
        for (int r = wave; r < 128; r += NWAVES) {
            const u32x4* p = (const u32x4*)(VS + (rb + r) * D) + 2 * lane; const u32x4 a = p[0], b = p[1]; float v[16];
#pragma unroll
            for (int k = 0; k < 4; ++k) { v[2 * k] = bf2f(a[k] & 0xffffu); v[2 * k + 1] = bf2f(a[k] >> 16); v[8 + 2 * k] = bf2f(b[k] & 0xffffu); v[8 + 2 * k + 1] = bf2f(b[k] >> 16); }
            float s = 0.f;
#pragma unroll
            for (int k = 0; k < 16; ++k) s += v[k];
            const float mu = wave_sum(s) * (1.0f / D); float qq = 0.f;
#pragma unroll
            for (int k = 0; k < 16; ++k) { const float d = v[k] - mu; qq += d * d; }
            const float rstd = 1.0f / sqrtf(wave_sum(qq) * (1.0f / D) + EPS);
            if (lane == 0) ST[r] = (f32x2){mu, rstd};
        }
        __syncthreads();
        for (int g = 0; g < 8; ++g) {
            {
                const int qq = tid & 127, chb = tid >> 7; const f32x2 st = ST[qq];
                const u32x4* p = (const u32x4*)(VS + (rb + qq) * D + g * 128 + chb * 32);
#pragma unroll
                for (int k4 = 0; k4 < 4; ++k4) { const u32x4 a = p[k4];
#pragma unroll
                    for (int k = 0; k < 4; ++k) { const int ch = chb * 32 + k4 * 8 + 2 * k; const int cg = g * 128 + ch;
                        const float y0 = (bf2f(a[k] & 0xffffu) - st[0]) * st[1] * lng[cg] + lnb[cg], y1 = (bf2f(a[k] >> 16) - st[0]) * st[1] * lng[cg + 1] + lnb[cg + 1];
                        const unsigned pk = cvt_pk_bf16(y0, y1); BS[ch * BST + qq] = (bf16_t)(pk & 0xffffu); BS[(ch + 1) * BST + qq] = (bf16_t)(pk >> 16); } }
            }
            __syncthreads();
            const int wm = wave >> 1, wn = wave & 1, fr = lane & 15, fq = lane >> 4;
            f32x4 acc[2][4];
#pragma unroll
            for (int i = 0; i < 2; ++i)
#pragma unroll
                for (int j = 0; j < 4; ++j) acc[i][j] = (f32x4){0.f, 0.f, 0.f, 0.f};
#pragma unroll
            for (int ks = 0; ks < 4; ++ks) {
                bf16x8 af[2], bfr[4];
#pragma unroll
                for (int i = 0; i < 2; ++i) af[i] = *(const LAS bf16x8*)(BS + (wm * 32 + i * 16 + fr) * BST + ks * 32 + fq * 8);
#pragma unroll
                for (int j = 0; j < 4; ++j) bfr[j] = *(const bf16x8*)(WSP + ((size_t)g * 128 + wn * 64 + j * 16 + fr) * 128 + ks * 32 + fq * 8);
#pragma unroll
                for (int i = 0; i < 2; ++i)
#pragma unroll
                    for (int j = 0; j < 4; ++j) acc[i][j] = __builtin_amdgcn_mfma_f32_16x16x32_bf16(af[i], bfr[j], acc[i][j], 0, 0, 0);
            }
#pragma unroll
            for (int j = 0; j < 4; ++j) { const int p = wn * 64 + j * 16 + fr; const float bsv = bs[g * 128 + p];
#pragma unroll
                for (int i = 0; i < 2; ++i) { const int ch = g * 128 + wm * 32 + i * 16 + 4 * fq;
                    const u32x2 uu = *(const u32x2*)(U + (rb + p) * D + ch);
                    const float o0 = bf2f(uu.x & 0xffffu) * (acc[i][j][0] + bsv), o1 = bf2f(uu.x >> 16) * (acc[i][j][1] + bsv), o2 = bf2f(uu.y & 0xffffu) * (acc[i][j][2] + bsv), o3 = bf2f(uu.y >> 16) * (acc[i][j][3] + bsv);
                    u32x2 w; w.x = cvt_pk_bf16(o0, o1); w.y = cvt_pk_bf16(o2, o3); *(u32x2*)(A + (rb + p) * D + ch) = w; } }
            __syncthreads();
        }
    }
}
namespace attn_body {
using bf16x8 = __attribute__((ext_vector_type(8))) short;
using s16x4 = __attribute__((ext_vector_type(4))) short;
using f32x16 = __attribute__((ext_vector_type(16))) float;
using u32x4 = __attribute__((ext_vector_type(4))) unsigned;
typedef unsigned short bf16;
constexpr int D = 64, DM = 1024, KP = 256;
constexpr int NW = 8, QBLK = 32, QB = QBLK * NW, KVBLK = 64, NT = 4352 / KVBLK;
__device__ __forceinline__ int crow(int r, int hi) { return (r & 3) + 8 * (r >> 2) + 4 * hi; }
#define SBAR() __builtin_amdgcn_sched_barrier(0)
constexpr int NSLOT = 3, SLOTB = 8192;
constexpr int LDS_K = 0, LDS_V = NSLOT * SLOTB, LDS_WS = 2 * NSLOT * SLOTB, LDS_OST = LDS_WS + NW * 64 * 4, LDS_BYTES = LDS_OST + NW * 4096;
__device__ __forceinline__ void glds16(const void* gsrc, unsigned lds_dst) { unsigned keep;
    asm volatile("s_mov_b32 %0, m0\n\ts_mov_b32 m0, %2\n\ts_nop 0\n\tglobal_load_lds_dwordx4 %1, off\n\ts_mov_b32 m0, %0" : "=&s"(keep) : "v"(gsrc), "s"(lds_dst) : "memory"); }
__device__ __forceinline__ float max3f(float a, float b, float c) { float r; asm("v_max3_f32 %0, %1, %2, %3" : "=v"(r) : "v"(a), "v"(b), "v"(c)); return r; }
__device__ __forceinline__ float max2f(float a, float b) { float r; asm("v_max_f32_e32 %0, %1, %2" : "=v"(r) : "v"(a), "v"(b)); return r; }
__device__ __forceinline__ float fadd_s(float a, float b) { float r; asm("v_add_f32_e32 %0, %1, %2" : "=v"(r) : "v"(a), "v"(b)); return r; }
__device__ __forceinline__ float fsub_s(float a, float b) { float r; asm("v_sub_f32_e32 %0, %1, %2" : "=v"(r) : "v"(a), "v"(b)); return r; }
typedef float f32x2_t __attribute__((ext_vector_type(2))); typedef __bf16 bf16x2_t __attribute__((ext_vector_type(2)));
__device__ __forceinline__ unsigned cvtpk_s(float lo, float hi) { f32x2_t v = {lo, hi}; bf16x2_t b = __builtin_convertvector(v, bf16x2_t); return __builtin_bit_cast(unsigned, b); }
#define WAIT_BAR(N) asm volatile("s_waitcnt vmcnt(" #N ") lgkmcnt(0)\n\ts_barrier" ::: "memory")
__device__ __forceinline__ void qkt(f32x16& p0, f32x16& p1, const char* Kslot, const bf16x8* qr, const f32x16& negm, int r32, int hi) {
    const char* kb = Kslot + hi * 1024 + r32 * 16;
#pragma unroll
    for (int d0 = 0; d0 < 4; ++d0) {
        const bf16x8 b0 = *reinterpret_cast<const bf16x8*>(kb + d0 * 2048);
        const bf16x8 b1 = *reinterpret_cast<const bf16x8*>(kb + d0 * 2048 + 512);
        if (d0 == 0) { p0 = __builtin_amdgcn_mfma_f32_32x32x16_bf16(b0, qr[0], negm, 0, 0, 0); p1 = __builtin_amdgcn_mfma_f32_32x32x16_bf16(b1, qr[0], negm, 0, 0, 0); }
        else { p0 = __builtin_amdgcn_mfma_f32_32x32x16_bf16(b0, qr[d0], p0, 0, 0, 0); p1 = __builtin_amdgcn_mfma_f32_32x32x16_bf16(b1, qr[d0], p1, 0, 0, 0); } }
}
typedef __attribute__((address_space(3))) const char* lds_cptr;
typedef short v4i16_t __attribute__((ext_vector_type(4)));
__device__ __forceinline__ void kload8(bf16x8* kf, lds_cptr kp) {
    kf[0] = *(const __attribute__((address_space(3))) bf16x8*)(kp);        kf[1] = *(const __attribute__((address_space(3))) bf16x8*)(kp + 512);
    kf[2] = *(const __attribute__((address_space(3))) bf16x8*)(kp + 2048); kf[3] = *(const __attribute__((address_space(3))) bf16x8*)(kp + 2560);
    kf[4] = *(const __attribute__((address_space(3))) bf16x8*)(kp + 4096); kf[5] = *(const __attribute__((address_space(3))) bf16x8*)(kp + 4608);
    kf[6] = *(const __attribute__((address_space(3))) bf16x8*)(kp + 6144); kf[7] = *(const __attribute__((address_space(3))) bf16x8*)(kp + 6656);
}
__device__ __forceinline__ void kload2(bf16x8* kf, lds_cptr kp, int j) { kf[2 * j] = *(const __attribute__((address_space(3))) bf16x8*)(kp + j * 2048); kf[2 * j + 1] = *(const __attribute__((address_space(3))) bf16x8*)(kp + j * 2048 + 512); }
__device__ __forceinline__ s16x4 vtr(lds_cptr p) { return __builtin_bit_cast(s16x4, __builtin_amdgcn_ds_read_tr16_b64_v4i16((__attribute__((address_space(3))) v4i16_t*)p)); }
__device__ __forceinline__ float rowmax(const f32x16& p0, const f32x16& p1) {
    float a = max3f(p0[0], p0[1], p1[0]), b = max3f(p0[2], p0[3], p1[1]); a = max3f(a, p1[2], p1[3]);
#pragma unroll
    for (int r = 4; r < 16; r += 4) { a = max3f(a, p0[r], p0[r + 1]); b = max3f(b, p0[r + 2], p0[r + 3]); a = max3f(a, p1[r], p1[r + 1]); b = max3f(b, p1[r + 2], p1[r + 3]); }
    const float m = max2f(a, b);
    auto rr = __builtin_amdgcn_permlane32_swap(__float_as_uint(m), __float_as_uint(m), false, false);
    return max2f(__uint_as_float(rr[0]), __uint_as_float(rr[1]));
}
__device__ __forceinline__ void pv(f32x16* o, int vb, bf16x8 pa0, bf16x8 pa1, bf16x8 pa2, bf16x8 pa3) {
#pragma unroll
    for (int d0 = 0; d0 < 2; ++d0) { s16x4 lo[4], hi[4];
#pragma unroll
        for (int ks = 0; ks < 4; ++ks) {
            asm volatile("ds_read_b64_tr_b16 %0,%1 offset:%c2" : "=&v"(lo[ks]) : "v"(vb), "i"(d0 * 4096 + ks * 1024) : "memory");
            asm volatile("ds_read_b64_tr_b16 %0,%1 offset:%c2" : "=&v"(hi[ks]) : "v"(vb), "i"(d0 * 4096 + ks * 1024 + 512) : "memory"); }
        asm volatile("s_waitcnt lgkmcnt(0)" ::: "memory"); SBAR();
#define PK(k) (bf16x8){lo[k][0], lo[k][1], lo[k][2], lo[k][3], hi[k][0], hi[k][1], hi[k][2], hi[k][3]}
        o[d0] = __builtin_amdgcn_mfma_f32_32x32x16_bf16(pa0, PK(0), o[d0], 0, 0, 0);
        o[d0] = __builtin_amdgcn_mfma_f32_32x32x16_bf16(pa1, PK(1), o[d0], 0, 0, 0);
        o[d0] = __builtin_amdgcn_mfma_f32_32x32x16_bf16(pa2, PK(2), o[d0], 0, 0, 0);
        o[d0] = __builtin_amdgcn_mfma_f32_32x32x16_bf16(pa3, PK(3), o[d0], 0, 0, 0);
#undef PK
    }
}
#define ATTN_STORE16(p, v) (*(u32x4*)(p) = (v))
template <int THRL> __device__ __forceinline__ void attn_unit(const bf16* Qw0, const bf16* __restrict__ Kh, const bf16* __restrict__ Vh, bf16* Ow0, char* shm) {
    const int tid = mk::fresh_tid(), lane = tid & 63, r32 = lane & 31, hi = lane >> 5; const int wid = __builtin_amdgcn_readfirstlane(tid >> 6);
    const bf16* Qw = Qw0 + (long)(wid * QBLK) * DM;
    const unsigned lds0 = (unsigned)(uintptr_t)shm;
    float* wsf = (float*)(shm + LDS_WS) + wid * 64;
    const bf16* ksrc = Kh + (long)lane * KP + wid * 8;
    const bf16* vsrc = Vh + (long)(16 * (wid & 3) + (lane >> 2)) * KP + (wid >> 2) * 32 + (lane & 3) * 8;
    const unsigned kdst = lds0 + LDS_K + wid * 1024, vdst = lds0 + LDS_V + wid * 1024;
#define DMA_K(t, slot) glds16(ksrc + (long)(t) * KVBLK * KP, (unsigned)__builtin_amdgcn_readfirstlane(kdst + (slot)))
#define DMA_V(t, slot) glds16(vsrc + (long)(t) * KVBLK * KP, (unsigned)__builtin_amdgcn_readfirstlane(vdst + (slot)))
    const int vb0 = (int)(lds0 + LDS_V) + ((lane >> 4) & 1) * 32 + (lane & 3) * 8 + (4 * hi + ((lane & 15) >> 2)) * 64;
    const char* Kbase = shm + LDS_K; bf16x8 kf[8];
    const lds_cptr shm3 = (lds_cptr)shm; const lds_cptr kp0 = shm3 + LDS_K + hi * 1024 + r32 * 16; const lds_cptr vp0 = shm3 + LDS_V + ((lane >> 4) & 1) * 32 + (lane & 3) * 8 + (4 * hi + ((lane & 15) >> 2)) * 64;
    DMA_K(0, 0); DMA_V(0, 0); DMA_K(1, SLOTB);
    bf16x8 qr[4];
#pragma unroll
    for (int d0 = 0; d0 < 4; ++d0) qr[d0] = *reinterpret_cast<const bf16x8*>(&Qw[(long)r32 * DM + d0 * 16 + hi * 8]);
    float mhat = 0.f, l_reg = 0.f; f32x16 o[2]; o[0] = f32x16{}; o[1] = f32x16{}; f32x16 negm = f32x16{}; asm volatile("" : "+v"(negm));
    bool resc = false;
#define START(P0, P1) do { const float rm = rowmax(P0, P1); resc = false; \
    { const float dl = rm; mhat = fadd_s(mhat, dl); \
      _Pragma("unroll") for (int r = 0; r < 16; ++r) { P0[r] = fsub_s(P0[r], dl); P1[r] = fsub_s(P1[r], dl); } \
      _Pragma("unroll") for (int r = 0; r < 16; ++r) negm[r] = -mhat; asm volatile("" : "+v"(negm)); } \
    _Pragma("unroll") for (int r = 0; r < 16; ++r) P0[r] = __builtin_amdgcn_exp2f(P0[r]); } while (0)
#define RESC() do { if (resc) { asm volatile("s_waitcnt lgkmcnt(0)" ::: "memory"); \
      _Pragma("unroll") for (int d_ = 0; d_ < 2; ++d_) _Pragma("unroll") for (int r = 0; r < 16; ++r) o[d_][r] *= wsf[crow(r, hi)]; } } while (0)
    f32x16 pA0, pA1, pB0, pB1;
    int sl_prev = 0, sl_cur = 0, sl_next = SLOTB;
#define ROT() do { sl_prev = sl_cur; sl_cur = sl_next; sl_next = (sl_next == (NSLOT - 1) * SLOTB) ? 0 : sl_next + SLOTB; } while (0)
    DMA_K(2, 2 * SLOTB);
    WAIT_BAR(3);
    qkt(pA0, pA1, Kbase, qr, negm, r32, hi); asm volatile("s_nop 15\n\ts_nop 7" : "+v"(pA0), "+v"(pA1));
    START(pA0, pA1);
    _Pragma("unroll") for (int r = 0; r < 16; ++r) pA1[r] = __builtin_amdgcn_exp2f(pA1[r]);
    WAIT_BAR(0);
    DMA_K(3, 0); DMA_V(1, SLOTB);
    ROT();
    kload8(kf, kp0 + sl_cur);
    WAIT_BAR(2);
    s16x4 vlo[8], vhi[8]; u32x4 pw0, pw1, pw2, pw3;
#define PKW(P, B) cvtpk_s(P[B], P[B + 1])
#define PAF(k) __builtin_bit_cast(bf16x8, pw##k)
#define VFR(i) (bf16x8){vlo[i][0], vlo[i][1], vlo[i][2], vlo[i][3], vhi[i][0], vhi[i][1], vhi[i][2], vhi[i][3]}
#define PIN(x) asm volatile("" : "+v"(x))
#define MX3(a, b, c) __builtin_fmaxf(__builtin_fmaxf((a), (b)), (c))
#define GAPA(MF, A0, A1, A2, A3, W0, W1, PW) do { MF; sacc += A0; sacc += A1; sacc += A2; sacc += A3; PIN(sacc); W0; W1; PIN(PW); SBAR(); } while (0)
#define EX(v) __builtin_amdgcn_exp2f(v)
#define GAPB(MF, X, B) do { MF; X[B] = EX(X[B]); X[B + 1] = EX(X[B + 1]); X[B + 2] = EX(X[B + 2]); X[B + 3] = EX(X[B + 3]); PIN(X); SBAR(); } while (0)
#define VRD(i) do { vlo[i] = vtr(vp_ + (((i) >> 2) * 4096 + ((i) & 3) * 1024)); vhi[i] = vtr(vp_ + (((i) >> 2) * 4096 + ((i) & 3) * 1024 + 512)); } while (0)
#define KRD(G, j) do { if (G) { kload2(kf, kp0 + sl_next, j); SBAR(); } } while (0)
#define STEP(C0, C1, P0, P1, t, GK, GV, GL) do { SBAR(); \
    const lds_cptr vp_ = vp0 + sl_prev; \
    VRD(0); SBAR(); float sacc = (P0[0] + P0[1]); \
    GAPA(C0 = __builtin_amdgcn_mfma_f32_32x32x16_bf16(kf[0], qr[0], negm, 0, 0, 0), P0[2], P0[3], P0[4], P0[5],     pw0[0] = PKW(P0, 0), pw0[1] = PKW(P0, 2), pw0); \
    VRD(4); SBAR(); GAPA(C1 = __builtin_amdgcn_mfma_f32_32x32x16_bf16(kf[1], qr[0], negm, 0, 0, 0), P0[6], P0[7], P0[8], P0[9],     pw0[2] = PKW(P0, 4), pw0[3] = PKW(P0, 6), pw0); \
    VRD(1); SBAR(); GAPA(C0 = __builtin_amdgcn_mfma_f32_32x32x16_bf16(kf[2], qr[1], C0, 0, 0, 0),   P0[10], P0[11], P0[12], P0[13], pw1[0] = PKW(P0, 8), pw1[1] = PKW(P0, 10), pw1); \
    VRD(5); SBAR(); GAPA(C1 = __builtin_amdgcn_mfma_f32_32x32x16_bf16(kf[3], qr[1], C1, 0, 0, 0),   P0[14], P0[15], P1[0], P1[1],   pw1[2] = PKW(P0, 12), pw1[3] = PKW(P0, 14), pw1); \
    VRD(2); SBAR(); GAPA(C0 = __builtin_amdgcn_mfma_f32_32x32x16_bf16(kf[4], qr[2], C0, 0, 0, 0),   P1[2], P1[3], P1[4], P1[5],     pw2[0] = PKW(P1, 0), pw2[1] = PKW(P1, 2), pw2); \
    VRD(6); SBAR(); GAPA(C1 = __builtin_amdgcn_mfma_f32_32x32x16_bf16(kf[5], qr[2], C1, 0, 0, 0),   P1[6], P1[7], P1[8], P1[9],     pw2[2] = PKW(P1, 4), pw2[3] = PKW(P1, 6), pw2); \
    VRD(3); SBAR(); GAPA(C0 = __builtin_amdgcn_mfma_f32_32x32x16_bf16(kf[6], qr[3], C0, 0, 0, 0),   P1[10], P1[11], P1[12], P1[13], pw3[0] = PKW(P1, 8), pw3[1] = PKW(P1, 10), pw3); \
    VRD(7); SBAR(); GAPA(C1 = __builtin_amdgcn_mfma_f32_32x32x16_bf16(kf[7], qr[3], C1, 0, 0, 0),   P1[14], P1[15], 0.f, 0.f,       pw3[2] = PKW(P1, 12), pw3[3] = PKW(P1, 14), pw3); \
    l_reg += sacc; \
    if (GK) { DMA_K((t) + 3, sl_cur); } if (GV) { DMA_V((t) + 1, sl_next); } \
    { float a = MX3(C0[0], C0[1], C1[0]), b = MX3(C0[2], C0[3], C1[1]); a = MX3(a, C1[2], C1[3]); \
      _Pragma("unroll") for (int r = 4; r < 16; r += 4) { a = MX3(a, C0[r], C0[r + 1]); b = MX3(b, C0[r + 2], C0[r + 3]); a = MX3(a, C1[r], C1[r + 1]); b = MX3(b, C1[r + 2], C1[r + 3]); } \
      float rm = __builtin_fmaxf(a, b); { auto rr = __builtin_amdgcn_permlane32_swap(__float_as_uint(rm), __float_as_uint(rm), false, false); rm = __builtin_fmaxf(__uint_as_float(rr[0]), __uint_as_float(rr[1])); } \
      resc = false; \
      if (__builtin_expect(__any(rm > (float)THRL), 0)) { const float dl = __builtin_fmaxf(rm, 0.f); mhat += dl; \
        _Pragma("unroll") for (int r = 0; r < 16; ++r) { C0[r] -= dl; C1[r] -= dl; } \
        _Pragma("unroll") for (int r = 0; r < 16; ++r) negm[r] = -mhat; asm volatile("" : "+v"(negm)); \
        const float f = __builtin_amdgcn_exp2f(-dl); l_reg *= f; if (hi == 0) wsf[r32] = f; resc = true; } } \
    SBAR(); \
    GAPB(o[0] = __builtin_amdgcn_mfma_f32_32x32x16_bf16(PAF(0), VFR(0), o[0], 0, 0, 0), C0, 0); \
    GAPB(o[1] = __builtin_amdgcn_mfma_f32_32x32x16_bf16(PAF(0), VFR(4), o[1], 0, 0, 0), C0, 4); \
    KRD(GL, 0); GAPB(o[0] = __builtin_amdgcn_mfma_f32_32x32x16_bf16(PAF(1), VFR(1), o[0], 0, 0, 0), C0, 8); \
    KRD(GL, 1); GAPB(o[1] = __builtin_amdgcn_mfma_f32_32x32x16_bf16(PAF(1), VFR(5), o[1], 0, 0, 0), C0, 12); \
    KRD(GL, 2); GAPB(o[0] = __builtin_amdgcn_mfma_f32_32x32x16_bf16(PAF(2), VFR(2), o[0], 0, 0, 0), C1, 0); \
    KRD(GL, 3); GAPB(o[1] = __builtin_amdgcn_mfma_f32_32x32x16_bf16(PAF(2), VFR(6), o[1], 0, 0, 0), C1, 4); \
    GAPB(o[0] = __builtin_amdgcn_mfma_f32_32x32x16_bf16(PAF(3), VFR(3), o[0], 0, 0, 0), C1, 8); \
    GAPB(o[1] = __builtin_amdgcn_mfma_f32_32x32x16_bf16(PAF(3), VFR(7), o[1], 0, 0, 0), C1, 12); \
    } while (0)
    int t = 1;
    for (; t + 5 < NT; t += 2) {
        STEP(pB0, pB1, pA0, pA1, t, true, true, true);     WAIT_BAR(2); RESC(); ROT();
        STEP(pA0, pA1, pB0, pB1, t + 1, true, true, true); WAIT_BAR(2); RESC(); ROT();
    }
#define ENDW(tt) do { if ((tt) + 3 < NT) { WAIT_BAR(2); } else if ((tt) + 2 < NT) { WAIT_BAR(1); } else { WAIT_BAR(0); } } while (0)
    for (; t + 1 < NT; t += 2) {
        STEP(pB0, pB1, pA0, pA1, t, (t + 3 < NT), (t + 1 < NT), (t + 1 < NT));         ENDW(t);     RESC(); ROT();
        STEP(pA0, pA1, pB0, pB1, t + 1, (t + 4 < NT), (t + 2 < NT), (t + 2 < NT));     ENDW(t + 1); RESC(); ROT();
    }
    STEP(pB0, pB1, pA0, pA1, NT - 1, false, false, false); RESC();
    { float sacc = pB0[0] + pB0[1]; _Pragma("unroll") for (int r = 2; r < 16; ++r) sacc += pB0[r]; _Pragma("unroll") for (int r = 0; r < 16; ++r) sacc += pB1[r]; l_reg += sacc;
      pw0 = (u32x4){PKW(pB0, 0), PKW(pB0, 2), PKW(pB0, 4), PKW(pB0, 6)}; pw1 = (u32x4){PKW(pB0, 8), PKW(pB0, 10), PKW(pB0, 12), PKW(pB0, 14)}; pw2 = (u32x4){PKW(pB1, 0), PKW(pB1, 2), PKW(pB1, 4), PKW(pB1, 6)}; pw3 = (u32x4){PKW(pB1, 8), PKW(pB1, 10), PKW(pB1, 12), PKW(pB1, 14)};
      SBAR(); pv(o, vb0 + sl_cur, PAF(0), PAF(1), PAF(2), PAF(3)); }
#undef PKW
#undef PAF
#undef VFR
#undef PIN
#undef MX3
#undef GAPA
#undef GAPB
#undef EX
#undef VRD
#undef KRD
#undef STEP
#undef ENDW
    { auto rr = __builtin_amdgcn_permlane32_swap(__float_as_uint(l_reg), __float_as_uint(l_reg), false, false); l_reg = __uint_as_float(rr[0]) + __uint_as_float(rr[1]); }
    if (hi == 0) wsf[32 + r32] = l_reg; asm volatile("s_waitcnt lgkmcnt(0)" ::: "memory");
    float rli[16];
#pragma unroll
    for (int r = 0; r < 16; ++r) rli[r] = __builtin_amdgcn_rcpf(wsf[32 + crow(r, hi)]);
    bf16* Ow = Ow0 + (long)(wid * QBLK) * DM;
    { bf16* stg = (bf16*)(shm + LDS_OST) + wid * 2048;
#pragma unroll
      for (int r = 0; r < 16; ++r) { const int orow = crow(r, hi);
#pragma unroll
          for (int d0 = 0; d0 < 2; ++d0) { const unsigned pk = cvtpk_s(o[d0][r] * rli[r], 0.f); stg[orow * 64 + d0 * 32 + r32] = (bf16)(pk & 0xffffu); } }
      asm volatile("s_waitcnt lgkmcnt(0)" ::: "memory");
#pragma unroll
      for (int i = 0; i < 4; ++i) { const int row = i * 8 + (lane >> 3), ch = lane & 7; const u32x4 v = *(const u32x4*)(stg + row * 64 + ch * 8); ATTN_STORE16(Ow + (long)row * DM + ch * 8, v); } }
    asm volatile("s_waitcnt lgkmcnt(0)\n\ts_barrier" ::: "memory");
#undef DMA_K
#undef DMA_V
#undef START
#undef RESC
#undef ROT
}
#undef SBAR
#undef WAIT_BAR
}

#ifndef MK_PHMASK
#define MK_PHMASK 0xffffffffu
#endif
#define PHON(k) (((MK_PHMASK) >> (k)) & 1u)
struct Args { const float* in[29]; float* out; unsigned char* ws; int ph_lo, ph_hi; };
static_assert(sizeof(Args) == 29 * 8 + 8 + 8 + 8, "Args has no padding");

template <int LAYER> __device__ __forceinline__ void moe_phases(Frame& F, const XcdBarrier& bar, int lo, int hi, int k0, int nrows) {
#define IN(k) (PHON(k) && lo <= (k) && (k) < hi)
#define BOTH(k) (IN(k) && (lo <= (k) + 1 && (k) + 1 < hi))
    if (IN(k0)) { route_phase(F, LAYER, nrows); if (BOTH(k0)) xcd_barrier(bar); }
    if (IN(k0 + 1)) {
        const int ntile = moe_table(F, LAYER);
        Moe1Sched S; S.m.tab = (const volatile LAS int*)(F.lds + TAB_OFF); S.m.vcu = F.vcu; S.m.G = F.G; S.m.ntile = ntile;
        S.H2 = (const char*)(F.ws + WS_H2); S.Wgu = (const char*)(F.ws + WS_WGU) + (size_t)LAYER * 16 * 512 * 2048; S.list = (const i32x4*)(F.ws + WS_LIST);
        EpiMoe1 E; E.F = &F;
        pg8::Gemm g{2048, 2048, 16, 16};
        pg8::gemm_phase<EpiMoe1, Moe1Sched, true>(F.lds, g, S, E);
        if (BOTH(k0 + 1)) xcd_barrier(bar);
    }
    if (IN(k0 + 2)) {
        const int ntile = moe_table(F, LAYER);
        Moe2Sched S; S.m.tab = (const volatile LAS int*)(F.lds + TAB_OFF); S.m.vcu = F.vcu; S.m.G = F.G; S.m.ntile = ntile;
        S.HID = (const char*)(F.ws + WS_HID); S.Wd = (const char*)(F.ws + WS_WD) + (size_t)LAYER * 16 * 1024 * 512; S.list = (const i32x4*)(F.ws + WS_LIST);
        EpiMoe2 E; E.F = &F; E.layer = LAYER;
        pg8::Gemm g{1024, 512, 8, 4};
        pg8::gemm_phase<EpiMoe2, Moe2Sched, true>(F.lds, g, S, E);
        if (BOTH(k0 + 2)) xcd_barrier(bar);
    }
#undef IN
#undef BOTH
}

__global__ void __launch_bounds__(NTHR, 2) mk_fwd(Args args) {
    extern __shared__ __attribute__((aligned(16))) unsigned char lds_raw[];
    Frame F;
    F.lds = (LAS unsigned char*)lds_raw;
    F.MISC = (volatile LAS unsigned*)(F.lds + MISC_OFF);
    F.G = gridDim.x; { const int bx = blockIdx.x; F.vcu = (F.G % 8 == 0) ? (bx % 8) * (F.G / 8) + bx / 8 : bx; }
#pragma unroll
    for (int i = 0; i < 29; ++i) F.in[i] = args.in[i];
    F.out = args.out; F.ws = args.ws; F.ctl = (gu32*)(args.ws + WS_CTL);
    for (int u = threadIdx.x; u < (LDS_BYTES - LDSCTL_OFF) / 4; u += NTHR) ((LAS unsigned*)(F.lds + LDSCTL_OFF))[u] = 0u;
    __syncthreads();
    const int lo = args.ph_lo, hi = args.ph_hi;
    XcdBarrier bar; bar.bar = (unsigned*)(F.ctl + CW_BAR); bar.x = 0; bar.st = nullptr;
    if (hi - lo > 1) bar = xcd_barrier_post((unsigned*)(F.ctl + CW_BAR), F.MISC + 8);
#define IN(k) (PHON(k) && lo <= (k) && (k) < hi)
#define BOTH(k) (IN(k) && (lo <= (k) + 1 && (k) + 1 < hi))
#define GRID_BAR(k) do { if (BOTH(k)) xcd_barrier(bar); } while (0)
    float* XC = (float*)(F.ws + WS_XC);
    if (IN(0)) { p0_prologue(F); GRID_BAR(0); }
    if (IN(1)) { pool_phase(F, 0, NROW / 64, F.in[I_X], F.in[I_CTX]); GRID_BAR(1); }
    if (IN(2)) {
        DenseSched S; S.A = (const char*)(F.ws + WS_A); S.B = (const char*)(F.ws + WS_WPOOL); S.nN = 4; S.nunits = (NROW / 256) * 4; S.vcu = F.vcu; S.G = F.G; S.a_tile = 256 * 2048; S.b_tile = 256 * 512; S.a_coloff = 512; S.pm0 = 0;
        EpiResid E; E.F = &F; E.layer = 0; E.bias = F.in[I_POOLB]; E.mul = F.in[I_POOLLS]; E.xin_lat = F.in[I_X]; E.xin_ctx = F.in[I_CTX];
        pg8::Gemm g{2048, 512, 4, 4};
        pg8::gemm_phase<EpiResid, DenseSched, true>(F.lds, g, S, E);
        GRID_BAR(2);
    }
    moe_phases<0>(F, bar, lo, hi, 3, NROW);
    if (IN(6)) { norm_phase(F, 1, NROW); GRID_BAR(6); }
    if (IN(7)) {
        QkvSched S; S.A = (const char*)(F.ws + WS_A); S.B = (const char*)(F.ws + WS_WQKV); S.vcu = F.vcu; S.G = F.G;
        EpiQkv E; E.F = &F; E.qg = F.in[I_QG]; E.kg = F.in[I_KG];
        pg8::Gemm g{2048, 2048, 16, 16};
        pg8::gemm_phase<EpiQkv, QkvSched, true>(F.lds, g, S, E);
        GRID_BAR(7);
    }
    if (IN(8)) {
        const attn_body::bf16* Q = (const attn_body::bf16*)(F.ws + WS_Q); const attn_body::bf16* K = (const attn_body::bf16*)(F.ws + WS_K); const attn_body::bf16* V = (const attn_body::bf16*)(F.ws + WS_V);
        attn_body::bf16* O = (attn_body::bf16*)(F.ws + WS_A);
        const int x = F.vcu >> 5, j = F.vcu & 31;
        for (int i = 0; i < 8; ++i) {
            const int combo = x * 4 + (i >> 1), sub = (i & 1) * 32 + j, gq = sub >> 4, qb = sub & 15, b = combo >> 2, hkv = combo & 3, h = hkv * 4 + gq;
            const size_t qrow = (size_t)b * SEQ + qb * 256;
            attn_body::attn_unit<8>(Q + qrow * D + h * 64, K + (size_t)b * KVROWS * KVP + hkv * 64, V + (size_t)b * KVROWS * KVP + hkv * 64, O + qrow * D + h * 64, (char*)lds_raw);
        }
        GRID_BAR(8);
    }
    if (IN(9)) {
        DenseSched S; S.A = (const char*)(F.ws + WS_A); S.B = (const char*)(F.ws + WS_WO); S.nN = 4; S.nunits = (NLAT / 256) * 4; S.vcu = F.vcu; S.G = F.G; S.a_tile = 256 * 2048; S.b_tile = 256 * 2048; S.a_coloff = 0; S.pm0 = 0;
        EpiResid E; E.F = &F; E.layer = 1; E.bias = nullptr; E.mul = nullptr; E.xin_lat = F.out; E.xin_ctx = XC;
        pg8::Gemm g{2048, 2048, 16, 16};
        pg8::gemm_phase<EpiResid, DenseSched, true>(F.lds, g, S, E);
        GRID_BAR(9);
    }
    moe_phases<1>(F, bar, lo, hi, 10, NLAT);
    if (IN(13)) { norm_phase(F, 2, NLAT); GRID_BAR(13); }
    if (IN(14)) {
        DenseSched S; S.A = (const char*)(F.ws + WS_A); S.B = (const char*)(F.ws + WS_WIN); S.nN = 8; S.nunits = (NLAT / 256) * 8; S.vcu = F.vcu; S.G = F.G; S.a_tile = 256 * 2048; S.b_tile = 256 * 2048; S.a_coloff = 0; S.pm0 = 0;
        EpiSgu1 E; E.F = &F; E.bin = F.in[I_BIN];
        pg8::Gemm g{2048, 2048, 16, 16};
        pg8::gemm_phase<EpiSgu1, DenseSched, true>(F.lds, g, S, E);
        GRID_BAR(14);
    }
    if (IN(15)) { sgu_spatial_phase(F); GRID_BAR(15); }
    if (IN(16)) {
        DenseSched S; S.A = (const char*)(F.ws + WS_A); S.B = (const char*)(F.ws + WS_WOUT); S.nN = 4; S.nunits = (NLAT / 256) * 4; S.vcu = F.vcu; S.G = F.G; S.a_tile = 256 * 2048; S.b_tile = 256 * 2048; S.a_coloff = 0; S.pm0 = 0;
        EpiResid E; E.F = &F; E.layer = 2; E.bias = nullptr; E.mul = nullptr; E.xin_lat = F.out; E.xin_ctx = XC;
        pg8::Gemm g{2048, 2048, 16, 16};
        pg8::gemm_phase<EpiResid, DenseSched, true>(F.lds, g, S, E);
        GRID_BAR(16);
    }
    moe_phases<2>(F, bar, lo, hi, 17, NLAT);
    if (IN(20)) { pool_phase(F, 3, NLAT / 64, F.out, XC); GRID_BAR(20); }
    if (IN(21)) {
        DenseSched S; S.A = (const char*)(F.ws + WS_A); S.B = (const char*)(F.ws + WS_WPOOL) + (size_t)4 * 256 * 512; S.nN = 4; S.nunits = (NLAT / 256) * 4; S.vcu = F.vcu; S.G = F.G; S.a_tile = 256 * 2048; S.b_tile = 256 * 512; S.a_coloff = 512; S.pm0 = 0;
        EpiResid E; E.F = &F; E.layer = 3; E.bias = F.in[I_POOLB] + 1024; E.mul = F.in[I_POOLLS] + 1024; E.xin_lat = F.out; E.xin_ctx = XC;
        pg8::Gemm g{2048, 512, 4, 4};
        pg8::gemm_phase<EpiResid, DenseSched, true>(F.lds, g, S, E);
        GRID_BAR(21);
    }
    moe_phases<3>(F, bar, lo, hi, 22, NLAT);
#undef IN
#undef BOTH
#undef GRID_BAR
}

static int g_grid = 0;
static bool mk_setup() {
    if (g_grid) return g_grid > 0;
    int dev = 0, cus = 0;
    if (hipGetDevice(&dev) != hipSuccess || hipDeviceGetAttribute(&cus, hipDeviceAttributeMultiprocessorCount, dev) != hipSuccess) { g_grid = -1; return false; }
    if (hipFuncSetAttribute((const void*)mk_fwd, hipFuncAttributeMaxDynamicSharedMemorySize, LDS_BYTES) != hipSuccess) { g_grid = -1; return false; }
    int per_cu = 0; (void)hipOccupancyMaxActiveBlocksPerMultiprocessor(&per_cu, (const void*)mk_fwd, NTHR, LDS_BYTES); (void)hipGetLastError();
    if (per_cu < 1) fprintf(stderr, "mk: occupancy query says %d blocks per CU\n", per_cu);
    g_grid = cus;
    return true;
}
static void mk_launch_range(void* const* d_in, void* d_out, void* d_ws, hipStream_t stream, int lo, int hi) {
    Args a{};
    for (int i = 0; i < 29; ++i) a.in[i] = (const float*)d_in[i];
    a.out = (float*)d_out; a.ws = (unsigned char*)d_ws; a.ph_lo = lo; a.ph_hi = hi;
    hipLaunchKernelGGL(mk_fwd, dim3(g_grid), dim3(NTHR), LDS_BYTES, stream, a);
}
}
extern "C" void kernel_launch(void* const* d_in, const int* in_sizes, int n_in, void* d_out, int out_size, void* d_ws, size_t ws_size, hipStream_t stream) {
    if (!mk::mk_setup()) return;
    hipMemsetAsync((char*)d_ws + mk::WS_CTL, 0, mk::CTL_ZERO_BYTES, stream);
    mk::mk_launch_range(d_in, d_out, d_ws, stream, 0, mk::NPHASE);
}
```

```cpp
#include <hip/hip_runtime.h>
#include <cstdio>
#include <cstdint>
namespace mk {
#define LAS __attribute__((address_space(3)))
#define GAS __attribute__((address_space(1)))
typedef unsigned short bf16_t;
typedef short bf16x8 __attribute__((ext_vector_type(8)));
typedef float f32x4 __attribute__((ext_vector_type(4)));
typedef float f32x2 __attribute__((ext_vector_type(2)));
typedef unsigned u32x4 __attribute__((ext_vector_type(4)));
typedef unsigned u32x2 __attribute__((ext_vector_type(2)));
typedef int i32x4 __attribute__((ext_vector_type(4)));
typedef GAS unsigned gu32;
#define RLX_AGENT __ATOMIC_RELAXED, __HIP_MEMORY_SCOPE_AGENT
#define LDS_WAIT() asm volatile("s_waitcnt lgkmcnt(0)" ::: "memory")
#define VM_WAIT() asm volatile("s_waitcnt vmcnt(0)" ::: "memory")

constexpr int D = 1024, NLAT = 32768, NCTX = 2048, NROW = NLAT + NCTX, SEQ = 4096, CTXL = 256, KVROWS = SEQ + CTXL, KVP = 256;
constexpr float EPS = 1e-6f;
constexpr int NWAVES = 8, NTHR = 512;
constexpr int NPHASE = 25;

constexpr size_t MiB = 1u << 20;
constexpr size_t WS_CTL = 0, CTL_ZERO_BYTES = 1 * MiB;
constexpr size_t WS_MOD = 1 * MiB;
constexpr size_t WS_COS = WS_MOD + 896 * 1024, WS_SIN = WS_COS + 4096;
constexpr size_t WS_WQKV = 2 * MiB, WS_WO = 5 * MiB, WS_WIN = 7 * MiB, WS_WOUT = 11 * MiB, WS_WPOOL = 13 * MiB, WS_WSP = 14 * MiB;
constexpr size_t WS_WGU = 16 * MiB, WS_WD = 80 * MiB;
constexpr size_t WS_A = 120 * MiB, WS_H2 = WS_A;
constexpr size_t WS_X = 188 * MiB;
constexpr size_t WS_BIG = 256 * MiB;
constexpr size_t WS_Q = WS_BIG, WS_K = WS_BIG + 64 * MiB, WS_V = WS_BIG + 82 * MiB;
constexpr size_t WS_U = WS_BIG, WS_VS = WS_BIG + 64 * MiB;
constexpr size_t WS_HID = WS_BIG, WS_LIST = WS_BIG + 48 * MiB;
constexpr size_t WS_END = 384 * MiB;
constexpr int LIST_CAP = NROW;
constexpr int CW_TMO = 0, CW_CODE = 1, CW_BAR = 4096, CW_CNT = 8192;

constexpr int RING_BYTES = 131072, LDSCTL_OFF = RING_BYTES, MISC_OFF = LDSCTL_OFF + 320, TAB_OFF = MISC_OFF + 128;
constexpr int LDS_BYTES = 147456;

__device__ __forceinline__ unsigned cvt_pk_bf16(float lo, float hi) { unsigned r; asm volatile("v_cvt_pk_bf16_f32 %0, %1, %2" : "=v"(r) : "v"(lo), "v"(hi)); return r; }
__device__ __forceinline__ int fresh_tid() { int t = threadIdx.x; asm volatile("" : "+v"(t)); return t; }
__device__ __forceinline__ float bf2f(unsigned h) { return __uint_as_float(h << 16); }
__device__ __forceinline__ float wave_sum(float v) {
#pragma unroll
    for (int o = 1; o < 64; o <<= 1) v += __shfl_xor(v, o);
    return v;
}

#define XB_TMO      128
#define XB_XCNT(j)  (256  + 64 * (j))
#define XB_XSUB(j)  (1280 + 64 * (j))
#define XB_XGEN(j)  (2304 + 64 * (j))
#define XB_TOP      3328
#define XB_TOPGEN   3392
#define XCD_BAR_WORDS 3456
#define XB_SPIN_CAP (1u << 18)
__device__ __forceinline__ unsigned xb_ld(unsigned* p)              { return __hip_atomic_load(p, __ATOMIC_RELAXED, __HIP_MEMORY_SCOPE_AGENT); }
__device__ __forceinline__ unsigned xb_add(unsigned* p, unsigned v) { return __hip_atomic_fetch_add(p, v, __ATOMIC_RELAXED, __HIP_MEMORY_SCOPE_AGENT); }
__device__ __forceinline__ unsigned xb_xcc_id() { return (unsigned)__builtin_amdgcn_s_getreg((3 << 11) | 20) & 0xFu; }
#define XB_SPIN(cond, bar) do { unsigned _sp = 0; while (cond) { __builtin_amdgcn_s_sleep(1); \
    if ((++_sp & 255u) == 0u) { if (xb_ld(&(bar)[XB_TMO])) break; if (_sp > XB_SPIN_CAP) { atomicAdd(&(bar)[XB_TMO], 1u); break; } } } } while (0)
struct XcdBarrier { unsigned* bar; unsigned x; volatile LAS unsigned* st; };
__device__ __forceinline__ XcdBarrier xcd_barrier_post(unsigned* bar, volatile LAS unsigned* st) {
    XcdBarrier b; b.bar = bar; b.x = xb_xcc_id(); b.st = st;
    if (threadIdx.x == 0) (void)xb_add(&bar[XB_XCNT(b.x)], 1u);
    return b;
}
__device__ __forceinline__ void xcd_barrier_complete(unsigned* bar, unsigned x, unsigned& nloc, unsigned& nx) {
    const unsigned G = gridDim.x * gridDim.y * gridDim.z;
    unsigned sum, cnt, mine, sp = 0u;
    for (;;) {
        sum = 0u; cnt = 0u; mine = 0u;
#pragma unroll
        for (unsigned j = 0; j < 16; ++j) { const unsigned c = xb_ld(&bar[XB_XCNT(j)]); sum += c; cnt += (c > 0u) ? 1u : 0u; mine = (j == x) ? c : mine; }
        if (sum == G) break;
        __builtin_amdgcn_s_sleep(1);
        if ((++sp & 255u) == 0u) { if (xb_ld(&bar[XB_TMO])) break; if (sp > XB_SPIN_CAP) { atomicAdd(&bar[XB_TMO], 1u); break; } }
    }
    nloc = mine > 0u ? mine : 1u; nx = cnt > 0u ? cnt : 1u;
}
__device__ __forceinline__ void xcd_barrier(const XcdBarrier& b) {
    asm volatile("s_waitcnt vmcnt(0)" ::: "memory");
    __syncthreads();
    if (threadIdx.x == 0) {
        unsigned* bar = b.bar;
        __builtin_amdgcn_s_waitcnt(0);
        unsigned nloc = b.st[0], nx = b.st[1];
        if (nloc == 0u) { xcd_barrier_complete(bar, b.x, nloc, nx); b.st[0] = nloc; b.st[1] = nx; }
        const unsigned old = xb_add(&bar[XB_XSUB(b.x)], 1u);
        const unsigned gen = old / nloc;
        if (old + 1u == (gen + 1u) * nloc) {
            __builtin_amdgcn_fence(__ATOMIC_RELEASE, "agent");
            asm volatile("s_waitcnt vmcnt(0)" ::: "memory");
            const unsigned og = xb_add(&bar[XB_TOP], 1u);
            const unsigned tg = og / nx;
            if (og + 1u == (tg + 1u) * nx) xb_add(&bar[XB_TOPGEN], 1u);
            else XB_SPIN(xb_ld(&bar[XB_TOPGEN]) == tg, bar);
            __builtin_amdgcn_fence(__ATOMIC_ACQUIRE, "agent");
            xb_add(&bar[XB_XGEN(b.x)], 1u);
            asm volatile("s_waitcnt vmcnt(0)" ::: "memory");
        } else {
            XB_SPIN(xb_ld(&bar[XB_XGEN(b.x)]) == gen, bar);
            __builtin_amdgcn_fence(__ATOMIC_ACQUIRE, "agent");
            asm volatile("s_waitcnt vmcnt(0)" ::: "memory");
        }
    }
    __syncthreads();
}

namespace pg8 {
constexpr int BM = 256, BK = 64, HALF = 128, HTB = HALF * BK * 2, STAGE_BYTES = 8 * HTB;
__host__ __device__ __forceinline__ int lds_byte(int r, int c) { const int st = (r >> 4) * 2 + (c >> 5), rr = r & 15, cc = c & 31, ob = rr * 64 + cc * 2; return st * 1024 + (ob ^ (((ob >> 9) & 1) << 5)); }
__host__ __device__ __forceinline__ void stage_rc(int b, int& R, int& C) { const int st = b / 1024, sb = b % 1024, swz = sb ^ (((sb >> 9) & 1) << 5); R = (st >> 1) * 16 + swz / 64; C = (st & 1) * 32 + (swz % 64) / 2; }
__host__ __device__ __forceinline__ int perm32(int rho) { const int n = rho >> 4, i = rho & 15; return 8 * (i >> 2) + 4 * n + (i & 3); }

struct Unit { const char* a; const char* b0; const char* b1; const i32x4* glst; int pm, pn, aux; };
struct Gemm { int lda2, ldb2, nt, ksw; };

template <class Epi, class Sched, bool ALIGN_EPI>
__device__ __forceinline__ void gemm_phase(LAS unsigned char* lds, const Gemm g, const Sched& S, const Epi& E) {
    const int tid = fresh_tid(), wid = __builtin_amdgcn_readfirstlane(tid >> 6), lane = tid & 63, wr = wid >> 2, wc = wid & 3, fr = lane & 15, fq = lane >> 4;
    const int nt = g.nt;
    int Ra[2]; unsigned Ca[2], voffB[2];
#pragma unroll
    for (int i = 0; i < 2; ++i) { int R, C; stage_rc(tid * 16 + i * 8192, R, C); const int Rb = Epi::PERM ? ((R & ~31) + perm32(R & 31)) : R;
        Ra[i] = R; Ca[i] = (unsigned)C * 2u; voffB[i] = (unsigned)Rb * (unsigned)g.ldb2 + (unsigned)C * 2u; }
    const size_t kstep = (size_t)(BK * 2);
    const size_t hstepB = (size_t)HALF * g.ldb2;
    const unsigned ldsw = (unsigned)wid * 1024u;
    const int aoff = lds_byte(wr * 64 + fr, fq * 8), boff = lds_byte(wc * 32 + fr, fq * 8);
#define PG8_SA(b, h) (((b) * 2 + (h)) * HTB)
#define PG8_SB(b, h) ((4 + (b) * 2 + (h)) * HTB)
#define PG8_STAGE(bufoff, gbase, voff) do { _Pragma("unroll") for (int _i = 0; _i < 2; ++_i) \
        __builtin_amdgcn_global_load_lds((const unsigned*)((const char*)(gbase) + (voff)[_i]), (LAS unsigned*)(lds + (bufoff) + ldsw + _i * 8192), 16, 0, 0); } while (0)
#define PG8_STAGE2(bufoff, gbase, v0, v1) do { \
        __builtin_amdgcn_global_load_lds((const unsigned*)((const char*)(gbase) + (v0)), (LAS unsigned*)(lds + (bufoff) + ldsw), 16, 0, 0); \
        __builtin_amdgcn_global_load_lds((const unsigned*)((const char*)(gbase) + (v1)), (LAS unsigned*)(lds + (bufoff) + ldsw + 8192), 16, 0, 0); } while (0)
#define PG8_LDA(dst, b, h) do { _Pragma("unroll") for (int m = 0; m < 4; ++m) _Pragma("unroll") for (int k = 0; k < 2; ++k) dst[m][k] = *(const LAS bf16x8*)(lds + PG8_SA(b, h) + aoff + m * 2048 + k * 1024); } while (0)
#define PG8_LDB(dst, b, h) do { _Pragma("unroll") for (int n = 0; n < 2; ++n) _Pragma("unroll") for (int k = 0; k < 2; ++k) dst[n][k] = *(const LAS bf16x8*)(lds + PG8_SB(b, h) + boff + n * 2048 + k * 1024); } while (0)
#define PG8_MMA(ai, bj, At, Bt) do { __builtin_amdgcn_s_setprio(1); _Pragma("unroll") for (int m = 0; m < 4; ++m) _Pragma("unroll") for (int n = 0; n < 2; ++n) _Pragma("unroll") for (int k = 0; k < 2; ++k) \
        acc[ai][bj][m][n] = __builtin_amdgcn_mfma_f32_16x16x32_bf16(Bt[n][k], At[m][k], acc[ai][bj][m][n], 0, 0, 0); __builtin_amdgcn_s_setprio(0); } while (0)
#define PG8_WAIT_V(n) asm volatile("s_waitcnt vmcnt(" #n ")" ::: "memory")
#define PG8_WAIT_L(n) asm volatile("s_waitcnt lgkmcnt(" #n ")" ::: "memory")
#define PG8_BAR __builtin_amdgcn_s_barrier()
#define PG8_SCHED __builtin_amdgcn_sched_barrier(0)
    const size_t hstepA = (size_t)HALF * g.lda2;
    unsigned voffA[2];
#pragma unroll
    for (int i = 0; i < 2; ++i) voffA[i] = (unsigned)Ra[i] * (unsigned)g.lda2 + Ca[i];
#define PG8_AROWS(u, v) do { if constexpr (Sched::GATHER) { _Pragma("unroll") for (int _h = 0; _h < 2; ++_h) { const int _r0 = _h * HALF + Ra[0], _r1 = _h * HALF + Ra[1]; \
        const int _e0 = (u).glst[_r0].x, _e1 = (u).glst[_r1].x; v[_h] = (unsigned)((_r0 < (u).aux) ? _e0 : 0) | ((unsigned)((_r1 < (u).aux) ? _e1 : 0) << 16); } \
        asm volatile("" : "+v"(v[0]), "+v"(v[1])); } } while (0)
#define PG8_STAGE_A(bufoff, gbase, v, h) do { if constexpr (Sched::GATHER) { \
        __builtin_amdgcn_global_load_lds((const unsigned*)((const char*)(gbase) + (((v)[h] & 0xffffu) * (unsigned)g.lda2 + Ca[0])), (LAS unsigned*)(lds + (bufoff) + ldsw), 16, 0, 0); \
        __builtin_amdgcn_global_load_lds((const unsigned*)((const char*)(gbase) + (((v)[h] >> 16) * (unsigned)g.lda2 + Ca[1])), (LAS unsigned*)(lds + (bufoff) + ldsw + 8192), 16, 0, 0); } \
      else { PG8_STAGE(bufoff, (const char*)(gbase) + (h) * hstepA, voffA); } } while (0)
    Unit cur, nxt; int ui = 0;
    if (!S.next(0, cur)) return;
    f32x4 acc[2][2][4][2];
#pragma unroll
    for (int a = 0; a < 2; ++a)
#pragma unroll
        for (int b = 0; b < 2; ++b)
#pragma unroll
            for (int m = 0; m < 4; ++m)
#pragma unroll
                for (int n = 0; n < 2; ++n) acc[a][b][m][n] = (f32x4){0.f, 0.f, 0.f, 0.f};
    bf16x8 At[4][2], B0[2][2], B1[2][2];
    unsigned vA[2] = {0u, 0u}, vN[2] = {0u, 0u};
    PG8_AROWS(cur, vA);
    const char* cA = cur.a; const char* cB0 = cur.b0; const char* cB1 = cur.b1;
    PG8_STAGE(PG8_SB(0, 0), cB0, voffB); PG8_STAGE(PG8_SB(0, 1), cB0 + hstepB, voffB); PG8_STAGE_A(PG8_SA(0, 0), cA, vA, 0); PG8_STAGE_A(PG8_SA(0, 1), cA, vA, 1);
    if (wr == 1) PG8_BAR;
    PG8_WAIT_V(2); PG8_BAR;
    PG8_STAGE(PG8_SB(1, 0), cB0 + kstep, voffB); PG8_STAGE_A(PG8_SA(1, 0), cA + kstep, vA, 0); PG8_STAGE(PG8_SB(1, 1), cB0 + hstepB + kstep, voffB);
    PG8_WAIT_V(6); PG8_BAR;
    for (;;) {
        const bool has_next = S.next(ui + 1, nxt);
        if (has_next) { PG8_AROWS(nxt, vN); } else { vN[0] = vA[0]; vN[1] = vA[1]; }
        const char* nA = has_next ? nxt.a : cA; const char* nB = has_next ? nxt.b0 : cB0;
#pragma nounroll
        for (int t = 0; t < nt; t += 2) {
            const bool last = (t == nt - 2);
            const char* a1 = cA + (size_t)(t + 1) * kstep;
            const char* a2 = last ? nA : cA + (size_t)(t + 2) * kstep;
            const char* b2 = last ? nB : ((t + 2 < g.ksw) ? cB0 + (size_t)(t + 2) * kstep : cB1 + (size_t)(t + 2 - g.ksw) * kstep);
            const char* a3 = a2 + kstep; const char* b3 = b2 + kstep;
            unsigned vS[2]; vS[0] = last ? vN[0] : vA[0]; vS[1] = last ? vN[1] : vA[1];
            PG8_LDB(B0, 0, 0); PG8_LDB(B1, 0, 1); PG8_SCHED; PG8_LDA(At, 0, 0); PG8_STAGE_A(PG8_SA(1, 1), a1, vA, 1);
            PG8_WAIT_V(8); PG8_WAIT_L(0); PG8_BAR; PG8_MMA(0, 0, At, B0); PG8_MMA(0, 1, At, B1); PG8_BAR; PG8_SCHED;
            PG8_LDA(At, 0, 1); PG8_STAGE(PG8_SB(0, 0), b2, voffB); PG8_STAGE(PG8_SB(0, 1), b2 + hstepB, voffB); PG8_STAGE_A(PG8_SA(0, 0), a2, vS, 0);
            PG8_WAIT_V(8); PG8_WAIT_L(0); PG8_BAR; PG8_MMA(1, 0, At, B0); PG8_MMA(1, 1, At, B1); PG8_BAR; PG8_SCHED;
            PG8_LDB(B0, 1, 0); PG8_LDB(B1, 1, 1); PG8_SCHED; PG8_LDA(At, 1, 0); PG8_STAGE_A(PG8_SA(0, 1), a2, vS, 1);
            PG8_WAIT_V(8); PG8_WAIT_L(0); PG8_BAR; PG8_MMA(0, 0, At, B0); PG8_MMA(0, 1, At, B1); PG8_BAR; PG8_SCHED;
            PG8_LDA(At, 1, 1); PG8_STAGE(PG8_SB(1, 0), b3, voffB); PG8_STAGE(PG8_SB(1, 1), b3 + hstepB, voffB); PG8_STAGE_A(PG8_SA(1, 0), a3, vS, 0);
            PG8_WAIT_V(8); PG8_WAIT_L(0); PG8_BAR; PG8_MMA(1, 0, At, B0); PG8_MMA(1, 1, At, B1); PG8_BAR; PG8_SCHED;
        }
        if constexpr (ALIGN_EPI) { if (wr == 0) PG8_BAR; }
        { int t_e = threadIdx.x; asm volatile("" : "+v"(t_e)); const int fr_e = t_e & 15, fq_e = (t_e >> 4) & 3;
          E(acc, cur, wr, wc, fr_e, fq_e); }
        if (!has_next) break;
#pragma unroll
        for (int a = 0; a < 2; ++a)
#pragma unroll
            for (int b = 0; b < 2; ++b)
#pragma unroll
                for (int m = 0; m < 4; ++m)
#pragma unroll
                    for (int n = 0; n < 2; ++n) acc[a][b][m][n] = (f32x4){0.f, 0.f, 0.f, 0.f};
        cur = nxt; cA = nA; cB0 = nxt.b0; cB1 = nxt.b1; ++ui;
        vA[0] = vN[0]; vA[1] = vN[1];
        if constexpr (ALIGN_EPI) { if (wr == 1) PG8_BAR; }
    }
    PG8_WAIT_V(0);
    if constexpr (!ALIGN_EPI) { if (wr == 0) PG8_BAR; }
    PG8_BAR;
#undef PG8_SA
#undef PG8_SB
#undef PG8_STAGE
#undef PG8_STAGE2
#undef PG8_LDA
#undef PG8_LDB
#undef PG8_MMA
#undef PG8_WAIT_V
#undef PG8_WAIT_L
#undef PG8_BAR
#undef PG8_SCHED
#undef PG8_AROWS
#undef PG8_STAGE_A
}
}
struct Frame {
    LAS unsigned char* lds;
    volatile LAS unsigned* MISC;
    gu32* ctl;
    int vcu, G, dry;
    const float* in[29];
    float* out;
    unsigned char* ws;
};
enum { I_X = 0, I_C, I_CTX, I_CCTX, I_WMOD, I_BMOD, I_N1G, I_N2G, I_POOLW, I_POOLB, I_POOLLS, I_WQKV, I_QG, I_KG, I_WO, I_WIN, I_BIN, I_LNG, I_LNB, I_WS, I_BS, I_WOUT,
       I_WRG, I_BRG, I_WRE, I_BRE, I_WG, I_WU, I_WD };
__device__ __forceinline__ const float* modvec(const Frame& F, int layer, int row) {
    const int j = row < NLAT ? (row >> 12) : 8; return (const float*)(F.ws + WS_MOD) + (size_t)(layer * 9 + j) * 6144; }
__device__ __forceinline__ bf16_t* xrow(const Frame& F, int row) { return (bf16_t*)(F.ws + WS_X) + (size_t)row * D; }
__device__ __forceinline__ bf16_t* xrow_w(const Frame& F, int row) { return (bf16_t*)(F.ws + (F.dry ? WS_END : WS_X)) + (size_t)row * D; }
__device__ __forceinline__ void unpack8(const u32x4 v, float (&o)[8]) {
#pragma unroll
    for (int k = 0; k < 4; ++k) { o[2 * k] = bf2f(v[k] & 0xffffu); o[2 * k + 1] = bf2f(v[k] >> 16); } }

struct DenseSched {
    static constexpr bool GATHER = false;
    const char* A; const char* B; int nN, nunits, vcu, G; size_t a_tile, b_tile; int a_coloff, pm0;
    __device__ __forceinline__ bool next(int i, pg8::Unit& u) const {
        const int L = vcu + i * G; if (L >= nunits) return false;
        const int pm = L / nN + pm0, pn = L % nN;
        u.a = A + (size_t)pm * a_tile + (size_t)pn * a_coloff; u.b0 = B + (size_t)pn * b_tile; u.b1 = u.b0; u.glst = nullptr; u.pm = pm; u.pn = pn; u.aux = 256; return true;
    }
};
struct QkvSched {
    static constexpr bool GATHER = false;
    const char* A; const char* B; int vcu, G;
    __device__ __forceinline__ bool next(int i, pg8::Unit& u) const {
        const int L = vcu + i * G; int pm, pn;
        if (L < 128 * 6) { pm = L / 6; pn = L % 6; } else if (L < 128 * 6 + 16) { const int r = L - 768; pm = 128 + (r >> 1); pn = 4 + (r & 1); } else return false;
        u.a = A + (size_t)pm * (256 * 2048); u.b0 = B + (size_t)pn * (256 * 2048); u.b1 = u.b0; u.glst = nullptr; u.pm = pm; u.pn = pn; u.aux = 256; return true;
    }
};
struct MoeSched {
    static constexpr bool GATHER_DUMMY = false;
    const volatile LAS int* tab; int vcu, G, ntile;
    __device__ __forceinline__ bool find(int i, int& tile, int& pn, int& b, int& tin, int& valid) const {
        const int L = vcu + i * G; if (L >= ntile * 4) return false;
        tile = L >> 2; pn = L & 3; b = 0;
        for (int k = 1; k < 24; ++k) b += (tab[k] <= tile) ? 1 : 0;
        b = __builtin_amdgcn_readfirstlane(b);
        tin = tile - __builtin_amdgcn_readfirstlane(tab[b]); const int c = __builtin_amdgcn_readfirstlane(tab[32 + b]) - tin * 256; valid = c < 256 ? c : 256; return true;
    }
};
__device__ __forceinline__ void bucket_experts(int b, int& elo, int& ehi) { const int gs = b / 6, p = b % 6; const int lo = p < 3 ? 0 : (p < 5 ? 1 : 2), hi = p < 3 ? p + 1 : (p < 5 ? p - 1 : 3); elo = gs * 4 + lo; ehi = gs * 4 + hi; }
struct Moe1Sched {
    static constexpr bool GATHER = true;
    MoeSched m; const char* H2; const char* Wgu; const i32x4* list;
    __device__ __forceinline__ bool next(int i, pg8::Unit& u) const {
        int tile, pn, b, tin, valid; if (!m.find(i, tile, pn, b, tin, valid)) return false;
        int elo, ehi; bucket_experts(b, elo, ehi); const int e = pn < 2 ? elo : ehi;
        u.a = H2; u.b0 = Wgu + ((size_t)e * 512 + (size_t)(pn & 1) * 256) * 2048; u.b1 = u.b0; u.glst = list + (size_t)b * LIST_CAP + tin * 256; u.pm = tile; u.pn = pn; u.aux = valid; return true;
    }
};
struct Moe2Sched {
    static constexpr bool GATHER = false;
    MoeSched m; const char* HID; const char* Wd; const i32x4* list;
    __device__ __forceinline__ bool next(int i, pg8::Unit& u) const {
        int tile, pn, b, tin, valid; if (!m.find(i, tile, pn, b, tin, valid)) return false;
        int elo, ehi; bucket_experts(b, elo, ehi);
        u.a = HID + (size_t)tile * (256 * 1024); u.b0 = Wd + ((size_t)elo * 1024 + (size_t)pn * 256) * 512; u.b1 = Wd + ((size_t)ehi * 1024 + (size_t)pn * 256) * 512;
        u.glst = list + (size_t)b * LIST_CAP + tin * 256; u.pm = tile; u.pn = pn; u.aux = valid; return true;
    }
};

using pg8::Unit;
struct EpiResid {
    static constexpr bool PERM = true;
    Frame* F; int layer; const float* bias; const float* mul;
    __device__ __forceinline__ void operator()(const f32x4 (&acc)[2][2][4][2], const Unit& u, int wr, int wc, int fr, int fq) const {
        const int row0 = u.pm * 256;
        const float* gate = modvec(*F, layer, row0) + 2 * 1024;
        const int col0 = u.pn * 256 + wc * 32 + 8 * fq;
        const bf16_t* xin = xrow(*F, row0) + (size_t)(wr * 64 + fr) * D + col0;
        bf16_t* xo = xrow_w(*F, row0) + (size_t)(wr * 64 + fr) * D + col0;
        f32x4 gv[2][2], bv[2][2];
#pragma unroll
        for (int bj = 0; bj < 2; ++bj)
#pragma unroll
            for (int n = 0; n < 2; ++n) { const int c = col0 + bj * 128 + n * 4; gv[bj][n] = *(const f32x4*)(gate + c); bv[bj][n] = (f32x4){0.f, 0.f, 0.f, 0.f};
                if (bias) { bv[bj][n] = *(const f32x4*)(bias + c); gv[bj][n] = gv[bj][n] * *(const f32x4*)(mul + c); } }
#pragma unroll
        for (int rg = 0; rg < 8; rg += 4) {
            u32x4 xv[4][2];
#pragma unroll
            for (int k = 0; k < 4; ++k)
#pragma unroll
                for (int bj = 0; bj < 2; ++bj) xv[k][bj] = *(const u32x4*)(xin + (size_t)(((rg + k) >> 2) * 128 + ((rg + k) & 3) * 16) * D + bj * 128);
#pragma unroll
            for (int k = 0; k < 4; ++k)
#pragma unroll
                for (int bj = 0; bj < 2; ++bj) { float x8[8]; unpack8(xv[k][bj], x8);
                    const f32x4 o0 = (f32x4){x8[0], x8[1], x8[2], x8[3]} + gv[bj][0] * (acc[(rg + k) >> 2][bj][(rg + k) & 3][0] + bv[bj][0]);
                    const f32x4 o1 = (f32x4){x8[4], x8[5], x8[6], x8[7]} + gv[bj][1] * (acc[(rg + k) >> 2][bj][(rg + k) & 3][1] + bv[bj][1]);
                    u32x4 w; w.x = cvt_pk_bf16(o0[0], o0[1]); w.y = cvt_pk_bf16(o0[2], o0[3]); w.z = cvt_pk_bf16(o1[0], o1[1]); w.w = cvt_pk_bf16(o1[2], o1[3]);
                    *(u32x4*)(xo + (size_t)(((rg + k) >> 2) * 128 + ((rg + k) & 3) * 16) * D + bj * 128) = w; }
            asm volatile("" ::: "memory");
        }
    }
};
struct EpiQkv {
    static constexpr bool PERM = false;
    Frame* F; const float* qg; const float* kg;
    __device__ __forceinline__ void operator()(const f32x4 (&acc)[2][2][4][2], const Unit& u, int wr, int wc, int fr, int fq) const {
        const int row0 = u.pm * 256; const bool lat = row0 < NLAT; const int pn = u.pn;
        bf16_t* Q = (bf16_t*)(F->ws + WS_Q); bf16_t* K = (bf16_t*)(F->ws + WS_K); bf16_t* V = (bf16_t*)(F->ws + WS_V);
        if (pn == 5) {
#pragma unroll
            for (int ai = 0; ai < 2; ++ai)
#pragma unroll
                for (int m = 0; m < 4; ++m) { const int row = row0 + ai * 128 + wr * 64 + m * 16 + fr;
                    const size_t kvrow = lat ? (size_t)(row >> 12) * KVROWS + CTXL + (row & 4095) : (size_t)((row - NLAT) >> 8) * KVROWS + ((row - NLAT) & 255);
#pragma unroll
                    for (int bj = 0; bj < 2; ++bj)
#pragma unroll
                        for (int n = 0; n < 2; ++n) { const f32x4 v = acc[ai][bj][m][n]; u32x2 w; w.x = cvt_pk_bf16(v[0], v[1]); w.y = cvt_pk_bf16(v[2], v[3]);
                            *(u32x2*)(V + kvrow * KVP + bj * 128 + wc * 32 + n * 16 + 4 * fq) = w; } }
            return;
        }
        const bool isq = pn < 4; const float* gsrc = isq ? qg : kg;
        f32x4 gv[2][2];
#pragma unroll
        for (int bj = 0; bj < 2; ++bj)
#pragma unroll
            for (int n = 0; n < 2; ++n) gv[bj][n] = *(const f32x4*)(gsrc + 32 * bj + 16 * n + 4 * fq);
        const float qs = isq ? 0.125f * 1.4426950408889634f : 1.0f;
        const float* COS = (const float*)(F->ws + WS_COS); const float* SIN = (const float*)(F->ws + WS_SIN);
#pragma unroll
        for (int ai = 0; ai < 2; ++ai)
#pragma unroll
            for (int m = 0; m < 4; ++m) { const int row = row0 + ai * 128 + wr * 64 + m * 16 + fr;
                float ss = 0.f;
#pragma unroll
                for (int bj = 0; bj < 2; ++bj)
#pragma unroll
                    for (int n = 0; n < 2; ++n) { const f32x4 v = acc[ai][bj][m][n]; ss += (v[0] * v[0] + v[1] * v[1]) + (v[2] * v[2] + v[3] * v[3]); }
                ss += __shfl_xor(ss, 16); ss += __shfl_xor(ss, 32);
                const float rstd = 1.0f / sqrtf(ss * (1.0f / 64.0f) + EPS);
                bf16_t* dst;
                if (isq) dst = Q + (size_t)row * D + (pn * 4 + wc) * 64;
                else { const size_t kvrow = lat ? (size_t)(row >> 12) * KVROWS + CTXL + (row & 4095) : (size_t)((row - NLAT) >> 8) * KVROWS + ((row - NLAT) & 255); dst = K + kvrow * KVP + wc * 64; }
                const int t = row & 4095;
#pragma unroll
                for (int bj = 0; bj < 2; ++bj) {
                    f32x4 x1 = acc[ai][bj][m][0] * rstd * gv[bj][0], x2 = acc[ai][bj][m][1] * rstd * gv[bj][1];
                    if (lat) { const int pos = bj == 0 ? (t >> 6) : (t & 63);
                        const f32x4 c = *(const f32x4*)(COS + pos * 16 + 4 * fq), s = *(const f32x4*)(SIN + pos * 16 + 4 * fq);
                        const f32x4 o1 = x1 * c - x2 * s, o2 = x2 * c + x1 * s; x1 = o1; x2 = o2; }
                    x1 = x1 * qs; x2 = x2 * qs;
                    u32x2 w1, w2; w1.x = cvt_pk_bf16(x1[0], x1[1]); w1.y = cvt_pk_bf16(x1[2], x1[3]); w2.x = cvt_pk_bf16(x2[0], x2[1]); w2.y = cvt_pk_bf16(x2[2], x2[3]);
                    *(u32x2*)(dst + 32 * bj + 4 * fq) = w1; *(u32x2*)(dst + 32 * bj + 16 + 4 * fq) = w2; } }
    }
};
struct EpiSgu1 {
    static constexpr bool PERM = true;
    Frame* F; const float* bin;
    __device__ __forceinline__ void operator()(const f32x4 (&acc)[2][2][4][2], const Unit& u, int wr, int wc, int fr, int fq) const {
        bf16_t* O = (bf16_t*)(F->ws + (u.pn < 4 ? WS_U : WS_VS)); const int ct = (u.pn & 3) * 256;
        const int col0 = wc * 32 + 8 * fq;
#pragma unroll
        for (int bj = 0; bj < 2; ++bj) {
            const f32x4 b0 = *(const f32x4*)(bin + u.pn * 256 + col0 + bj * 128), b1 = *(const f32x4*)(bin + u.pn * 256 + col0 + bj * 128 + 4);
#pragma unroll
            for (int ai = 0; ai < 2; ++ai)
#pragma unroll
                for (int m = 0; m < 4; ++m) { const int row = u.pm * 256 + ai * 128 + wr * 64 + m * 16 + fr;
                    f32x4 v0 = acc[ai][bj][m][0] + b0, v1 = acc[ai][bj][m][1] + b1; float o[8];
#pragma unroll
                    for (int e = 0; e < 8; ++e) { const float v = e < 4 ? v0[e] : v1[e - 4]; const float t = 1.5957691216057308f * (v + 0.044715f * v * v * v);
                        o[e] = v * __builtin_amdgcn_rcpf(1.0f + __builtin_amdgcn_exp2f(-1.4426950408889634f * t)); }
                    u32x4 w; w.x = cvt_pk_bf16(o[0], o[1]); w.y = cvt_pk_bf16(o[2], o[3]); w.z = cvt_pk_bf16(o[4], o[5]); w.w = cvt_pk_bf16(o[6], o[7]);
                    *(u32x4*)(O + (size_t)row * D + ct + col0 + bj * 128) = w; } }
    }
};
struct EpiMoe1 {
    static constexpr bool PERM = true;
    Frame* F;
    __device__ __forceinline__ void operator()(const f32x4 (&acc)[2][2][4][2], const Unit& u, int wr, int wc, int fr, int fq) const {
        bf16_t* HID = (bf16_t*)(F->ws + WS_HID); const int col0 = (u.pn >> 1) * 256 + (u.pn & 1) * 128 + wc * 32 + 8 * fq;
#pragma unroll
        for (int ai = 0; ai < 2; ++ai)
#pragma unroll
            for (int m = 0; m < 4; ++m) { const int rr = ai * 128 + wr * 64 + m * 16 + fr;
                const i32x4 e = u.glst[rr]; const float w = (rr < u.aux) ? __int_as_float((u.pn >> 1) ? e.z : e.y) : 0.f;
                float o[8];
#pragma unroll
                for (int k = 0; k < 8; ++k) { const float gt = k < 4 ? acc[ai][0][m][0][k] : acc[ai][0][m][1][k - 4], up = k < 4 ? acc[ai][1][m][0][k] : acc[ai][1][m][1][k - 4];
                    o[k] = gt * __builtin_amdgcn_rcpf(1.0f + __builtin_amdgcn_exp2f(-1.4426950408889634f * gt)) * up * w; }
                u32x4 pk; pk.x = cvt_pk_bf16(o[0], o[1]); pk.y = cvt_pk_bf16(o[2], o[3]); pk.z = cvt_pk_bf16(o[4], o[5]); pk.w = cvt_pk_bf16(o[6], o[7]);
                *(u32x4*)(HID + ((size_t)u.pm * 256 + rr) * 512 + col0) = pk; asm volatile("" ::: "memory"); }
    }
};
template <bool LAST> struct EpiMoe2 {
    static constexpr bool PERM = true;
    Frame* F; int layer;
    __device__ __forceinline__ void operator()(const f32x4 (&acc)[2][2][4][2], const Unit& u, int wr, int wc, int fr, int fq) const {
        const int col0 = u.pn * 256 + wc * 32 + 8 * fq;
        int rows[8];
#pragma unroll
        for (int rg = 0; rg < 8; ++rg) { const int rr = (rg >> 2) * 128 + wr * 64 + (rg & 3) * 16 + fr; const int e = u.glst[rr].x; rows[rg] = rr < u.aux ? e : -1; }
#pragma unroll
        for (int rg = 0; rg < 8; rg += 2) {
            u32x4 xv[2][2]; f32x4 gv[2][2][2];
#pragma unroll
            for (int k = 0; k < 2; ++k) { const int row = rows[rg + k] < 0 ? 0 : rows[rg + k]; const float* gate = modvec(*F, layer, row) + 5 * 1024 + col0; const bf16_t* xi = xrow(*F, row) + col0;
#pragma unroll
                for (int bj = 0; bj < 2; ++bj) { xv[k][bj] = *(const u32x4*)(xi + bj * 128); gv[k][bj][0] = *(const f32x4*)(gate + bj * 128); gv[k][bj][1] = *(const f32x4*)(gate + bj * 128 + 4); } }
#pragma unroll
            for (int k = 0; k < 2; ++k) if (rows[rg + k] >= 0) {
#pragma unroll
                for (int bj = 0; bj < 2; ++bj) { float x8[8]; unpack8(xv[k][bj], x8);
                    const f32x4 o0 = (f32x4){x8[0], x8[1], x8[2], x8[3]} + gv[k][bj][0] * acc[(rg + k) >> 2][bj][(rg + k) & 3][0];
                    const f32x4 o1 = (f32x4){x8[4], x8[5], x8[6], x8[7]} + gv[k][bj][1] * acc[(rg + k) >> 2][bj][(rg + k) & 3][1];
                    if constexpr (LAST) { float* o = (F->dry ? (float*)(F->ws + WS_END) : F->out) + (size_t)rows[rg + k] * D + col0 + bj * 128; *(f32x4*)o = o0; *(f32x4*)(o + 4) = o1; }
                    else { u32x4 w; w.x = cvt_pk_bf16(o0[0], o0[1]); w.y = cvt_pk_bf16(o0[2], o0[3]); w.z = cvt_pk_bf16(o1[0], o1[1]); w.w = cvt_pk_bf16(o1[2], o1[3]);
                        *(u32x4*)(xrow_w(*F, rows[rg + k]) + col0 + bj * 128) = w; } } }
            asm volatile("" ::: "memory");
        }
    }
};

template <class RM> __device__ __forceinline__ void transpose_item(const float* W, int ldw, bf16_t* WT, int ldt, int k0, int n0, LAS float* scr, int lane, RM rm) {
#pragma unroll 8
    for (int i = 0; i < 32; ++i) { const int kk = 2 * i + (lane >> 5); scr[kk * 33 + (lane & 31)] = W[(size_t)(k0 + kk) * ldw + n0 + (lane & 31)]; }
    LDS_WAIT(); asm volatile("" ::: "memory");
    const int c = lane & 7;
#pragma unroll
    for (int j = 0; j < 4; ++j) { const int n = (lane >> 3) + 8 * j; const LAS float* s = scr + (8 * c) * 33 + n;
        u32x4 o; o.x = cvt_pk_bf16(s[0 * 33], s[1 * 33]); o.y = cvt_pk_bf16(s[2 * 33], s[3 * 33]); o.z = cvt_pk_bf16(s[4 * 33], s[5 * 33]); o.w = cvt_pk_bf16(s[6 * 33], s[7 * 33]);
        *(GAS u32x4*)(WT + (size_t)rm(n0 + n) * ldt + k0 + 8 * c) = o; }
    LDS_WAIT(); asm volatile("" ::: "memory");
}
struct RmId { __device__ __forceinline__ int operator()(int n) const { return n; } };
struct RmQkv { __device__ __forceinline__ int operator()(int n) const { const int t = n >> 8, lc = n & 255; return t < 5 ? t * 256 + 128 * ((lc >> 5) & 1) + 32 * (lc >> 6) + (lc & 31) : n; } };
struct RmGu { int up; __device__ __forceinline__ int operator()(int f) const { return (f >> 7) * 256 + up * 128 + (f & 127); } };

__device__ __forceinline__ void p0_prologue(Frame& F) {
    const int tid = fresh_tid(), lane = tid & 63, wave = __builtin_amdgcn_readfirstlane(tid >> 6);
    {
        LAS float* sl = (LAS float*)F.lds; LAS float* part = (LAS float*)(F.lds + 40960);
        for (int idx = tid; idx < 9 * 1024; idx += NTHR) { const int j = idx >> 10, k = idx & 1023; const float v = j < 8 ? F.in[I_C][j * 1024 + k] : F.in[I_CCTX][k]; sl[idx] = v / (1.0f + expf(-v)); }
        __syncthreads();
        for (int u = F.vcu; u < 384; u += F.G) {
            const int l = u / 96, cb = u % 96, col = cb * 64 + lane;
            const float* w = F.in[I_WMOD] + ((size_t)l * 1024 + wave * 128) * 6144 + col;
            float acc[9];
#pragma unroll
            for (int j = 0; j < 9; ++j) acc[j] = 0.f;
#pragma unroll 8
            for (int kk = 0; kk < 128; ++kk) { const float wv = w[(size_t)kk * 6144];
#pragma unroll
                for (int j = 0; j < 9; ++j) acc[j] += sl[j * 1024 + wave * 128 + kk] * wv; }
#pragma unroll
            for (int j = 0; j < 9; ++j) part[(wave * 9 + j) * 64 + lane] = acc[j];
            __syncthreads();
            for (int idx = tid; idx < 576; idx += NTHR) { const int j = idx >> 6, ln = idx & 63; float s = 0.f;
#pragma unroll
                for (int w8 = 0; w8 < 8; ++w8) s += part[(w8 * 9 + j) * 64 + ln];
                const int c6 = cb * 64 + ln; s += F.in[I_BMOD][l * 6144 + c6];
                const int which = c6 >> 10, d = c6 & 1023;
                if (which == 1) s = F.in[I_N1G][l * 1024 + d] * (1.0f + s);
                if (which == 4) s = F.in[I_N2G][l * 1024 + d] * (1.0f + s);
                ((float*)(F.ws + WS_MOD))[(size_t)(l * 9 + j) * 6144 + c6] = s; }
            __syncthreads();
        }
    }
    if (blockIdx.x == 1) { for (int idx = tid; idx < 1024; idx += NTHR) { const int pos = idx >> 4, i = idx & 15; const float ang = (float)pos * powf(10000.f, -(float)i / 16.f);
            ((float*)(F.ws + WS_COS))[idx] = cosf(ang); ((float*)(F.ws + WS_SIN))[idx] = sinf(ang); } }
    { const int gw0 = F.vcu * NWAVES + wave, NGW0 = F.G * NWAVES;
      for (int r = gw0; r < NROW; r += NGW0) { const float* src = r < NLAT ? F.in[I_X] + (size_t)r * D : F.in[I_CTX] + (size_t)(r - NLAT) * D;
#pragma unroll
          for (int h = 0; h < 2; ++h) { const f32x4 a = *(const f32x4*)(src + h * 512 + lane * 8), b = *(const f32x4*)(src + h * 512 + lane * 8 + 4);
              u32x4 o; o.x = cvt_pk_bf16(a[0], a[1]); o.y = cvt_pk_bf16(a[2], a[3]); o.z = cvt_pk_bf16(b[0], b[1]); o.w = cvt_pk_bf16(b[2], b[3]);
              *(u32x4*)((bf16_t*)(F.ws + WS_X) + (size_t)r * D + h * 512 + lane * 8) = o; } } }
    LAS float* scr = (LAS float*)(F.lds + wave * 8704);
    const int gw = F.vcu * NWAVES + wave, NGW = F.G * NWAVES;
    constexpr int S0 = 768, S1 = S0 + 512, S2 = S1 + 1024, S3 = S2 + 512, S4 = S3 + 256, S5 = S4 + 8192, S6 = S5 + 8192, S7 = S6 + 8192, S8 = S7 + 256;
    for (int it = gw; it < S8; it += NGW) {
        if (it < S0) { const int kb = it / 48, nb = it % 48; transpose_item(F.in[I_WQKV], 1536, (bf16_t*)(F.ws + WS_WQKV), 1024, kb * 64, nb * 32, scr, lane, RmQkv()); }
        else if (it < S1) { const int r = it - S0, kb = r / 32, nb = r % 32; transpose_item(F.in[I_WO], 1024, (bf16_t*)(F.ws + WS_WO), 1024, kb * 64, nb * 32, scr, lane, RmId()); }
        else if (it < S2) { const int r = it - S1, kb = r / 64, nb = r % 64; transpose_item(F.in[I_WIN], 2048, (bf16_t*)(F.ws + WS_WIN), 1024, kb * 64, nb * 32, scr, lane, RmId()); }
        else if (it < S3) { const int r = it - S2, kb = r / 32, nb = r % 32; transpose_item(F.in[I_WOUT], 1024, (bf16_t*)(F.ws + WS_WOUT), 1024, kb * 64, nb * 32, scr, lane, RmId()); }
        else if (it < S4) { const int r = it - S3, mat = r >> 5, q = r & 31, kb = q >> 3, nb = q & 7; transpose_item(F.in[I_POOLW] + (size_t)mat * 65536, 256, (bf16_t*)(F.ws + WS_WPOOL) + (size_t)mat * 65536, 256, kb * 64, nb * 32, scr, lane, RmId()); }
        else if (it < S5) { const int r = it - S4, mat = r >> 7, q = r & 127, kb = q >> 3, nb = q & 7; RmGu rm; rm.up = 0;
            transpose_item(F.in[I_WG] + (size_t)mat * 262144, 256, (bf16_t*)(F.ws + WS_WGU) + (size_t)mat * 524288, 1024, kb * 64, nb * 32, scr, lane, rm); }
        else if (it < S6) { const int r = it - S5, mat = r >> 7, q = r & 127, kb = q >> 3, nb = q & 7; RmGu rm; rm.up = 1;
            transpose_item(F.in[I_WU] + (size_t)mat * 262144, 256, (bf16_t*)(F.ws + WS_WGU) + (size_t)mat * 524288, 1024, kb * 64, nb * 32, scr, lane, rm); }
        else if (it < S7) { const int r = it - S6, mat = r >> 7, q = r & 127, kb = q >> 5, nb = q & 31;
            transpose_item(F.in[I_WD] + (size_t)mat * 262144, 1024, (bf16_t*)(F.ws + WS_WD) + (size_t)mat * 262144, 256, kb * 64, nb * 32, scr, lane, RmId()); }
        else { const int r = it - S7; const f32x4* s = (const f32x4*)(F.in[I_WS] + (size_t)r * 512 + lane * 8); const f32x4 a = s[0], b = s[1];
            u32x4 o; o.x = cvt_pk_bf16(a[0], a[1]); o.y = cvt_pk_bf16(a[2], a[3]); o.z = cvt_pk_bf16(b[0], b[1]); o.w = cvt_pk_bf16(b[2], b[3]);
            *(u32x4*)((bf16_t*)(F.ws + WS_WSP) + (size_t)r * 512 + lane * 8) = o; }
    }
}

__device__ __forceinline__ void norm_phase(Frame& F, int layer, int nrows) {
    const int tid = fresh_tid(), lane = tid & 63, wave = __builtin_amdgcn_readfirstlane(tid >> 6);
    const int gw = F.vcu * NWAVES + wave, NGW = F.G * NWAVES, rpw = (nrows + NGW - 1) / NGW; bf16_t* A = (bf16_t*)(F.ws + WS_A);
    for (int r = gw * rpw; r < (gw + 1) * rpw && r < nrows; ++r) {
        const float* mv = modvec(F, layer, r); const u32x4* xr = (const u32x4*)xrow(F, r) + 2 * lane;
        float v[16]; { float t8[8]; unpack8(xr[0], t8);
#pragma unroll
            for (int k = 0; k < 8; ++k) v[k] = t8[k];
            unpack8(xr[1], t8);
#pragma unroll
            for (int k = 0; k < 8; ++k) v[8 + k] = t8[k]; }
        float s = 0.f;
#pragma unroll
        for (int k = 0; k < 16; ++k) s += v[k] * v[k];
        const float rstd = 1.0f / sqrtf(wave_sum(s) * (1.0f / D) + EPS);
        u32x4 o[2];
#pragma unroll
        for (int j = 0; j < 4; ++j) { const f32x4 gm = ((const f32x4*)(mv + 1024))[4 * lane + j], sh = ((const f32x4*)mv)[4 * lane + j];
            const float y0 = v[4 * j] * rstd * gm[0] + sh[0], y1 = v[4 * j + 1] * rstd * gm[1] + sh[1], y2 = v[4 * j + 2] * rstd * gm[2] + sh[2], y3 = v[4 * j + 3] * rstd * gm[3] + sh[3];
            o[j >> 1][(j & 1) * 2] = cvt_pk_bf16(y0, y1); o[j >> 1][(j & 1) * 2 + 1] = cvt_pk_bf16(y2, y3); }
        u32x4* op = (u32x4*)(A + (size_t)r * D) + 2 * lane; op[0] = o[0]; op[1] = o[1];
    }
}
__device__ __forceinline__ void pool_phase(Frame& F, int layer, int ntile) {
    const int tid = fresh_tid(), lane = tid & 63, wave = __builtin_amdgcn_readfirstlane(tid >> 6);
    LAS float* rs = (LAS float*)F.lds;
    LAS float* XS = (LAS float*)(F.lds + 512);
    bf16_t* A = (bf16_t*)(F.ws + WS_A);
    for (int tile = F.vcu; tile < ntile; tile += F.G) {
        const int row0 = tile * 64; const bool lat = row0 < NLAT;
        const int n = lat ? SEQ : CTXL, sb = lat ? (row0 & ~(SEQ - 1)) : NLAT + ((row0 - NLAT) & ~(CTXL - 1)), t0 = row0 - sb;
        const bf16_t* xs = xrow(F, sb);
        const int jlo = t0 - 8 > 0 ? t0 - 8 : 0, jhi = t0 + 72 < n ? t0 + 72 : n, nj = jhi - jlo;
        for (int j = jlo + wave; j < jhi; j += NWAVES) { const u32x4* xr = (const u32x4*)(xs + (size_t)j * D) + 2 * lane; float a8[8], b8[8]; unpack8(xr[0], a8); unpack8(xr[1], b8); float s = 0.f;
#pragma unroll
            for (int k = 0; k < 8; ++k) s += a8[k] * a8[k] + b8[k] * b8[k];
            s = wave_sum(s); if (lane == 0) rs[j - jlo] = 1.0f / sqrtf(s * (1.0f / D) + EPS); }
        __syncthreads();
        for (int g = 0; g < 4; ++g) {
            { u32x4 ld[5];
#pragma unroll
              for (int k = 0; k < 5; ++k) { const int idx = tid + k * NTHR, j = idx >> 5, cc = idx & 31; ld[k] = (u32x4){0u, 0u, 0u, 0u}; if (j < nj) ld[k] = *(const u32x4*)(xs + (size_t)(jlo + j) * D + g * 256 + cc * 8); }
#pragma unroll
              for (int k = 0; k < 5; ++k) { const int idx = tid + k * NTHR, j = idx >> 5, cc = idx & 31; if (j < nj) { float v8[8]; unpack8(ld[k], v8); const float r = rs[j];
                  *(LAS f32x4*)(XS + j * 256 + cc * 8) = (f32x4){v8[0] * r, v8[1] * r, v8[2] * r, v8[3] * r}; *(LAS f32x4*)(XS + j * 256 + cc * 8 + 4) = (f32x4){v8[4] * r, v8[5] * r, v8[6] * r, v8[7] * r}; } } }
            __syncthreads();
            { const int h = 1 << g, c2 = 2 * (tid & 127), tq = tid >> 7, ts = t0 + 16 * tq;
              const f32x2 gm = *(const f32x2*)(modvec(F, layer, row0) + 1024 + g * 256 + c2);
              const LAS float* xc = XS + c2 - jlo * 256;
#define XR(j) (*(const LAS f32x2*)(xc + (j) * 256))
              f32x2 S = (f32x2){0.f, 0.f};
              { const int lo = ts - h > 0 ? ts - h : 0, hi = ts + h < n ? ts + h : n; for (int j = lo; j < hi; ++j) S += XR(j); }
#pragma unroll 4
              for (int t = ts; t < ts + 16; ++t) {
                  const int lo = t - h > 0 ? t - h : 0, hi = t + h < n ? t + h : n; const float inv = 1.0f / (float)(hi - lo);
                  const f32x2 p = gm * (S * inv - XR(t));
                  *(unsigned*)(A + (size_t)(sb + t) * D + g * 256 + c2) = cvt_pk_bf16(p[0], p[1]);
                  if (t - h >= 0) S -= XR(t - h);
                  if (t + h < n) S += XR(t + h);
              }
#undef XR
            }
            __syncthreads();
        }
    }
}
__device__ __forceinline__ void route_phase(Frame& F, int layer, int nrows) {
    constexpr int WTS = 1032;
    const int tid = fresh_tid(), lane = tid & 63, wave = __builtin_amdgcn_readfirstlane(tid >> 6);
    LAS bf16_t* WH = (LAS bf16_t*)F.lds;
    LAS bf16_t* WL = (LAS bf16_t*)(F.lds + 41472);
    LAS float* GS = (LAS float*)(F.lds + 82944);
    LAS float* LG = (LAS float*)(F.lds + 91136) + wave * (16 * 33);
    LAS i32x4* RES = (LAS i32x4*)(F.lds + 108032);
    LAS int* HIST = (LAS int*)(F.lds + 113152);
    const float* wrg = F.in[I_WRG] + (size_t)layer * 4096; const float* wre = F.in[I_WRE] + (size_t)layer * 16384;
    for (int idx = tid; idx < 20480; idx += NTHR) { float w; int e, k; if (idx < 4096) { e = idx & 3; k = idx >> 2; w = wrg[idx]; } else { const int i2 = idx - 4096; e = 4 + (i2 & 15); k = i2 >> 4; w = wre[i2]; }
        const unsigned hi = cvt_pk_bf16(w, 0.f) & 0xffffu; const unsigned lo = cvt_pk_bf16(w - bf2f(hi), 0.f) & 0xffffu; WH[e * WTS + k] = (bf16_t)hi; WL[e * WTS + k] = (bf16_t)lo; }
    if (tid < 96) HIST[tid] = 0;
    const int r16 = lane & 15, q = lane >> 4;
    const float* brg = F.in[I_BRG] + layer * 4; const float* bre = F.in[I_BRE] + layer * 16;
    bf16_t* H2 = (bf16_t*)(F.ws + WS_H2);
    const int ntile = nrows / 16, NGW = F.G * NWAVES, nround = (ntile + NGW - 1) / NGW;
    for (int rd = 0; rd < nround; ++rd) {
        const int tile = rd * NGW + F.vcu * NWAVES + wave;
        __syncthreads();
        { const float* mv = modvec(F, layer, (rd * NGW + F.vcu * NWAVES) * 16 < nrows ? (rd * NGW + F.vcu * NWAVES) * 16 : 0);
          for (int idx = tid; idx < 2048; idx += NTHR) GS[idx] = idx < 1024 ? mv[4 * 1024 + idx] : mv[3 * 1024 + idx - 1024]; }
        __syncthreads();
        if (tile < ntile) {
            const int row = tile * 16 + r16;
            const u32x4* xr = (const u32x4*)xrow(F, row) + q;
            u32x4 xd[32];
#pragma unroll
            for (int i = 0; i < 32; ++i) xd[i] = xr[4 * i];
            float ss = 0.f;
#pragma unroll
            for (int i = 0; i < 32; ++i) { float v8[8]; unpack8(xd[i], v8);
#pragma unroll
                for (int k = 0; k < 8; ++k) ss += v8[k] * v8[k]; }
            ss += __shfl_xor(ss, 16); ss += __shfl_xor(ss, 32);
            const float rstd = 1.0f / sqrtf(ss * (1.0f / D) + EPS);
#pragma unroll
            for (int i = 0; i < 32; ++i) asm volatile("" : "+v"(xd[i]));
            f32x4 acc0 = (f32x4){0.f, 0.f, 0.f, 0.f}, acc1 = acc0;
            const LAS bf16_t* wh0 = WH + r16 * WTS + 8 * q; const LAS bf16_t* wl0 = WL + r16 * WTS + 8 * q;
            const LAS bf16_t* wh1 = WH + (16 + (r16 & 3)) * WTS + 8 * q; const LAS bf16_t* wl1 = WL + (16 + (r16 & 3)) * WTS + 8 * q;
            u32x4* ho = (u32x4*)(H2 + (size_t)row * D) + q;
#pragma unroll
            for (int i = 0; i < 32; ++i) {
                float v8[8]; unpack8(xd[i], v8);
                const LAS f32x4* gp = (const LAS f32x4*)(GS + 32 * i + 8 * q); const LAS f32x4* sp = (const LAS f32x4*)(GS + 1024 + 32 * i + 8 * q);
                const f32x4 g0 = gp[0], g1 = gp[1], s0 = sp[0], s1 = sp[1];
                float h8[8];
#pragma unroll
                for (int k = 0; k < 4; ++k) { h8[k] = v8[k] * rstd * g0[k] + s0[k]; h8[4 + k] = v8[4 + k] * rstd * g1[k] + s1[k]; }
                u32x4 hi; hi.x = cvt_pk_bf16(h8[0], h8[1]); hi.y = cvt_pk_bf16(h8[2], h8[3]); hi.z = cvt_pk_bf16(h8[4], h8[5]); hi.w = cvt_pk_bf16(h8[6], h8[7]);
                ho[4 * i] = hi;
                float hf[8]; unpack8(hi, hf);
                u32x4 lo; lo.x = cvt_pk_bf16(h8[0] - hf[0], h8[1] - hf[1]); lo.y = cvt_pk_bf16(h8[2] - hf[2], h8[3] - hf[3]); lo.z = cvt_pk_bf16(h8[4] - hf[4], h8[5] - hf[5]); lo.w = cvt_pk_bf16(h8[6] - hf[6], h8[7] - hf[7]);
                const bf16x8 ah = __builtin_bit_cast(bf16x8, hi), al = __builtin_bit_cast(bf16x8, lo);
                const bf16x8 bh0 = *(const LAS bf16x8*)(wh0 + 32 * i), bl0 = *(const LAS bf16x8*)(wl0 + 32 * i), bh1 = *(const LAS bf16x8*)(wh1 + 32 * i), bl1 = *(const LAS bf16x8*)(wl1 + 32 * i);
                acc0 = __builtin_amdgcn_mfma_f32_16x16x32_bf16(ah, bh0, acc0, 0, 0, 0); acc0 = __builtin_amdgcn_mfma_f32_16x16x32_bf16(al, bh0, acc0, 0, 0, 0); acc0 = __builtin_amdgcn_mfma_f32_16x16x32_bf16(ah, bl0, acc0, 0, 0, 0);
                acc1 = __builtin_amdgcn_mfma_f32_16x16x32_bf16(ah, bh1, acc1, 0, 0, 0); acc1 = __builtin_amdgcn_mfma_f32_16x16x32_bf16(al, bh1, acc1, 0, 0, 0); acc1 = __builtin_amdgcn_mfma_f32_16x16x32_bf16(ah, bl1, acc1, 0, 0, 0);
                asm volatile("" ::: "memory");
            }
#pragma unroll
            for (int rg = 0; rg < 4; ++rg) { LG[(4 * q + rg) * 33 + r16] = acc0[rg]; LG[(4 * q + rg) * 33 + 16 + r16] = acc1[rg]; }
            LDS_WAIT(); asm volatile("" ::: "memory");
            if (lane < 16) {
                const LAS float* lg = LG + lane * 33;
                const float g0 = lg[0] + brg[0], g1 = lg[1] + brg[1], g2 = lg[2] + brg[2], g3 = lg[3] + brg[3];
                int gs = 0; float gm = g0; if (g1 > gm) { gm = g1; gs = 1; } if (g2 > gm) { gm = g2; gs = 2; } if (g3 > gm) { gm = g3; gs = 3; }
                const float gwt = 1.0f / (expf(g0 - gm) + expf(g1 - gm) + expf(g2 - gm) + expf(g3 - gm));
                const float e0 = lg[4 + gs * 4] + bre[gs * 4], e1 = lg[5 + gs * 4] + bre[gs * 4 + 1], e2 = lg[6 + gs * 4] + bre[gs * 4 + 2], e3 = lg[7 + gs * 4] + bre[gs * 4 + 3];
                int i1 = 0; float v1 = e0; if (e1 > v1) { v1 = e1; i1 = 1; } if (e2 > v1) { v1 = e2; i1 = 2; } if (e3 > v1) { v1 = e3; i1 = 3; }
                int i2 = -1; float v2 = -3.0e38f;
                if (i1 != 0 && e0 > v2) { v2 = e0; i2 = 0; } if (i1 != 1 && e1 > v2) { v2 = e1; i2 = 1; } if (i1 != 2 && e2 > v2) { v2 = e2; i2 = 2; } if (i1 != 3 && e3 > v2) { v2 = e3; i2 = 3; }
                const float ex = expf(v2 - v1), wa = gwt / (1.0f + ex), wb = gwt * ex / (1.0f + ex);
                const int lo = i1 < i2 ? i1 : i2, hi = i1 < i2 ? i2 : i1; const float wlo = i1 < i2 ? wa : wb, whi = i1 < i2 ? wb : wa;
                const int bucket = gs * 6 + lo * (7 - lo) / 2 + (hi - lo - 1);
                const int slot = __hip_atomic_fetch_add(&HIST[64], 1, __ATOMIC_RELAXED, __HIP_MEMORY_SCOPE_WORKGROUP), rank = __hip_atomic_fetch_add(&HIST[bucket], 1, __ATOMIC_RELAXED, __HIP_MEMORY_SCOPE_WORKGROUP);
                RES[slot] = (i32x4){tile * 16 + lane, bucket | (rank << 5), __float_as_int(wlo), __float_as_int(whi)};
            }
            LDS_WAIT(); asm volatile("" ::: "memory");
        }
    }
    __syncthreads();
    if (tid < 24) HIST[32 + tid] = (int)__hip_atomic_fetch_add(F.ctl + CW_CNT + 32 * (layer + (F.dry ? 4 : 0)) + tid, (unsigned)HIST[tid], RLX_AGENT);
    __syncthreads();
    i32x4* LIST = (i32x4*)(F.ws + WS_LIST);
    const int nres = HIST[64];
    for (int idx = tid; idx < nres; idx += NTHR) { const i32x4 e = RES[idx]; const int b = e.y & 31, rank = e.y >> 5; LIST[(size_t)b * LIST_CAP + HIST[32 + b] + rank] = (i32x4){e.x, e.z, e.w, 0}; }
    __syncthreads();
}
__device__ __forceinline__ int moe_table(Frame& F, int layer) {
    volatile LAS int* tab = (volatile LAS int*)(F.lds + TAB_OFF);
    if (threadIdx.x == 0) { int acc = 0;
        for (int b = 0; b < 24; ++b) { const int c = (int)__hip_atomic_load(F.ctl + CW_CNT + 32 * layer + b, RLX_AGENT); tab[b] = acc; tab[32 + b] = c; acc += (c + 255) >> 8; }
        tab[24] = acc; }
    __syncthreads();
    return tab[24];
}

__device__ __forceinline__ void sgu_spatial_phase(Frame& F) {
    constexpr int BST = 144;
    LAS f32x2* ST = (LAS f32x2*)F.lds;
    LAS bf16_t* BS = (LAS bf16_t*)(F.lds + 2048);
    const bf16_t* U = (const bf16_t*)(F.ws + WS_U); const bf16_t* VS = (const bf16_t*)(F.ws + WS_VS); const bf16_t* WSP = (const bf16_t*)(F.ws + WS_WSP); bf16_t* A = (bf16_t*)(F.ws + WS_A);
    const float* lng = F.in[I_LNG]; const float* lnb = F.in[I_LNB]; const float* bs = F.in[I_BS];
    const int tid = fresh_tid(), lane = tid & 63, wave = __builtin_amdgcn_readfirstlane(tid >> 6);
    for (int chunk = F.vcu; chunk < NLAT / 128; chunk += F.G) {
        const size_t rb = (size_t)chunk * 128;
        for (int r = wave; r < 128; r += NWAVES) {
            const u32x4* p = (const u32x4*)(VS + (rb + r) * D) + 2 * lane; const u32x4 a = p[0], b = p[1]; float v[16];
#pragma unroll
            for (int k = 0; k < 4; ++k) { v[2 * k] = bf2f(a[k] & 0xffffu); v[2 * k + 1] = bf2f(a[k] >> 16); v[8 + 2 * k] = bf2f(b[k] & 0xffffu); v[8 + 2 * k + 1] = bf2f(b[k] >> 16); }
            float s = 0.f;
#pragma unroll
            for (int k = 0; k < 16; ++k) s += v[k];
            const float mu = wave_sum(s) * (1.0f / D); float qq = 0.f;
#pragma unroll
            for (int k = 0; k < 16; ++k) { const float d = v[k] - mu; qq += d * d; }
            const float rstd = 1.0f / sqrtf(wave_sum(qq) * (1.0f / D) + EPS);
            if (lane == 0) ST[r] = (f32x2){mu, rstd};
        }
        __syncthreads();
        for (int g = 0; g < 8; ++g) {
            {
                const int qq = tid & 127, chb = tid >> 7; const f32x2 st = ST[qq];
                const u32x4* p = (const u32x4*)(VS + (rb + qq) * D + g * 128 + chb * 32);
#pragma unroll
                for (int k4 = 0; k4 < 4; ++k4) { const u32x4 a = p[k4];
#pragma unroll
                    for (int k = 0; k < 4; ++k) { const int ch = chb * 32 + k4 * 8 + 2 * k; const int cg = g * 128 + ch;
                        const float y0 = (bf2f(a[k] & 0xffffu) - st[0]) * st[1] * lng[cg] + lnb[cg], y1 = (bf2f(a[k] >> 16) - st[0]) * st[1] * lng[cg + 1] + lnb[cg + 1];
                        const unsigned pk = cvt_pk_bf16(y0, y1); BS[ch * BST + qq] = (bf16_t)(pk & 0xffffu); BS[(ch + 1) * BST + qq] = (bf16_t)(pk >> 16); } }
            }
            __syncthreads();
            const int wm = wave >> 1, wn = wave & 1, fr = lane & 15, fq = lane >> 4;
            f32x4 acc[2][4];
#pragma unroll
            for (int i = 0; i < 2; ++i)
#pragma unroll
                for (int j = 0; j < 4; ++j) acc[i][j] = (f32x4){0.f, 0.f, 0.f, 0.f};
#pragma unroll
            for (int ks = 0; ks < 4; ++ks) {
                bf16x8 af[2], bfr[4];
#pragma unroll
                for (int i = 0; i < 2; ++i) af[i] = *(const LAS bf16x8*)(BS + (wm * 32 + i * 16 + fr) * BST + ks * 32 + fq * 8);
#pragma unroll
                for (int j = 0; j < 4; ++j) bfr[j] = *(const bf16x8*)(WSP + ((size_t)g * 128 + wn * 64 + j * 16 + fr) * 128 + ks * 32 + fq * 8);
#pragma unroll
                for (int i = 0; i < 2; ++i)
#pragma unroll
                    for (int j = 0; j < 4; ++j) acc[i][j] = __builtin_amdgcn_mfma_f32_16x16x32_bf16(af[i], bfr[j], acc[i][j], 0, 0, 0);
            }
#pragma unroll
            for (int j = 0; j < 4; ++j) { const int p = wn * 64 + j * 16 + fr; const float bsv = bs[g * 128 + p];
#pragma unroll
                for (int i = 0; i < 2; ++i) { const int ch = g * 128 + wm * 32 + i * 16 + 4 * fq;
                    const u32x2 uu = *(const u32x2*)(U + (rb + p) * D + ch);
                    const float o0 = bf2f(uu.x & 0xffffu) * (acc[i][j][0] + bsv), o1 = bf2f(uu.x >> 16) * (acc[i][j][1] + bsv), o2 = bf2f(uu.y & 0xffffu) * (acc[i][j][2] + bsv), o3 = bf2f(uu.y >> 16) * (acc[i][j][3] + bsv);
                    u32x2 w; w.x = cvt_pk_bf16(o0, o1); w.y = cvt_pk_bf16(o2, o3); *(u32x2*)(A + (rb + p) * D + ch) = w; } }
            __syncthreads();
        }
    }
}
namespace attn_body {
using bf16x8 = __attribute__((ext_vector_type(8))) short;
using s16x4 = __attribute__((ext_vector_type(4))) short;
using f32x16 = __attribute__((ext_vector_type(16))) float;
using u32x4 = __attribute__((ext_vector_type(4))) unsigned;
typedef unsigned short bf16;
constexpr int D = 64, DM = 1024, KP = 256;
constexpr int NW = 8, QBLK = 32, QB = QBLK * NW, KVBLK = 64, NT = 4352 / KVBLK;
__device__ __forceinline__ int crow(int r, int hi) { return (r & 3) + 8 * (r >> 2) + 4 * hi; }
#define SBAR() __builtin_amdgcn_sched_barrier(0)
constexpr int NSLOT = 3, SLOTB = 8192;
constexpr int LDS_K = 0, LDS_V = NSLOT * SLOTB, LDS_WS = 2 * NSLOT * SLOTB, LDS_OST = LDS_WS + NW * 64 * 4, LDS_BYTES = LDS_OST + NW * 4096;
__device__ __forceinline__ void glds16(const void* gsrc, unsigned lds_dst) { unsigned keep;
    asm volatile("s_mov_b32 %0, m0\n\ts_mov_b32 m0, %2\n\ts_nop 0\n\tglobal_load_lds_dwordx4 %1, off\n\ts_mov_b32 m0, %0" : "=&s"(keep) : "v"(gsrc), "s"(lds_dst) : "memory"); }
__device__ __forceinline__ float max3f(float a, float b, float c) { float r; asm("v_max3_f32 %0, %1, %2, %3" : "=v"(r) : "v"(a), "v"(b), "v"(c)); return r; }
__device__ __forceinline__ float max2f(float a, float b) { float r; asm("v_max_f32_e32 %0, %1, %2" : "=v"(r) : "v"(a), "v"(b)); return r; }
__device__ __forceinline__ float fadd_s(float a, float b) { float r; asm("v_add_f32_e32 %0, %1, %2" : "=v"(r) : "v"(a), "v"(b)); return r; }
__device__ __forceinline__ float fsub_s(float a, float b) { float r; asm("v_sub_f32_e32 %0, %1, %2" : "=v"(r) : "v"(a), "v"(b)); return r; }
typedef float f32x2_t __attribute__((ext_vector_type(2))); typedef __bf16 bf16x2_t __attribute__((ext_vector_type(2)));
__device__ __forceinline__ unsigned cvtpk_s(float lo, float hi) { f32x2_t v = {lo, hi}; bf16x2_t b = __builtin_convertvector(v, bf16x2_t); return __builtin_bit_cast(unsigned, b); }
#define WAIT_BAR(N) asm volatile("s_waitcnt vmcnt(" #N ") lgkmcnt(0)\n\ts_barrier" ::: "memory")
__device__ __forceinline__ void qkt(f32x16& p0, f32x16& p1, const char* Kslot, const bf16x8* qr, const f32x16& negm, int r32, int hi) {
    const char* kb = Kslot + hi * 1024 + r32 * 16;
#pragma unroll
    for (int d0 = 0; d0 < 4; ++d0) {
        const bf16x8 b0 = *reinterpret_cast<const bf16x8*>(kb + d0 * 2048);
        const bf16x8 b1 = *reinterpret_cast<const bf16x8*>(kb + d0 * 2048 + 512);
        if (d0 == 0) { p0 = __builtin_amdgcn_mfma_f32_32x32x16_bf16(b0, qr[0], negm, 0, 0, 0); p1 = __builtin_amdgcn_mfma_f32_32x32x16_bf16(b1, qr[0], negm, 0, 0, 0); }
        else { p0 = __builtin_amdgcn_mfma_f32_32x32x16_bf16(b0, qr[d0], p0, 0, 0, 0); p1 = __builtin_amdgcn_mfma_f32_32x32x16_bf16(b1, qr[d0], p1, 0, 0, 0); } }
}
typedef __attribute__((address_space(3))) const char* lds_cptr;
typedef short v4i16_t __attribute__((ext_vector_type(4)));
__device__ __forceinline__ void kload8(bf16x8* kf, lds_cptr kp) {
    kf[0] = *(const __attribute__((address_space(3))) bf16x8*)(kp);        kf[1] = *(const __attribute__((address_space(3))) bf16x8*)(kp + 512);
    kf[2] = *(const __attribute__((address_space(3))) bf16x8*)(kp + 2048); kf[3] = *(const __attribute__((address_space(3))) bf16x8*)(kp + 2560);
    kf[4] = *(const __attribute__((address_space(3))) bf16x8*)(kp + 4096); kf[5] = *(const __attribute__((address_space(3))) bf16x8*)(kp + 4608);
    kf[6] = *(const __attribute__((address_space(3))) bf16x8*)(kp + 6144); kf[7] = *(const __attribute__((address_space(3))) bf16x8*)(kp + 6656);
}
__device__ __forceinline__ void kload2(bf16x8* kf, lds_cptr kp, int j) { kf[2 * j] = *(const __attribute__((address_space(3))) bf16x8*)(kp + j * 2048); kf[2 * j + 1] = *(const __attribute__((address_space(3))) bf16x8*)(kp + j * 2048 + 512); }
__device__ __forceinline__ s16x4 vtr(lds_cptr p) { return __builtin_bit_cast(s16x4, __builtin_amdgcn_ds_read_tr16_b64_v4i16((__attribute__((address_space(3))) v4i16_t*)p)); }
__device__ __forceinline__ float rowmax(const f32x16& p0, const f32x16& p1) {
    float a = max3f(p0[0], p0[1], p1[0]), b = max3f(p0[2], p0[3], p1[1]); a = max3f(a, p1[2], p1[3]);
#pragma unroll
    for (int r = 4; r < 16; r += 4) { a = max3f(a, p0[r], p0[r + 1]); b = max3f(b, p0[r + 2], p0[r + 3]); a = max3f(a, p1[r], p1[r + 1]); b = max3f(b, p1[r + 2], p1[r + 3]); }
    const float m = max2f(a, b);
    auto rr = __builtin_amdgcn_permlane32_swap(__float_as_uint(m), __float_as_uint(m), false, false);
    return max2f(__uint_as_float(rr[0]), __uint_as_float(rr[1]));
}
__device__ __forceinline__ void pv(f32x16* o, int vb, bf16x8 pa0, bf16x8 pa1, bf16x8 pa2, bf16x8 pa3) {
#pragma unroll
    for (int d0 = 0; d0 < 2; ++d0) { s16x4 lo[4], hi[4];
#pragma unroll
        for (int ks = 0; ks < 4; ++ks) {
            asm volatile("ds_read_b64_tr_b16 %0,%1 offset:%c2" : "=&v"(lo[ks]) : "v"(vb), "i"(d0 * 4096 + ks * 1024) : "memory");
            asm volatile("ds_read_b64_tr_b16 %0,%1 offset:%c2" : "=&v"(hi[ks]) : "v"(vb), "i"(d0 * 4096 + ks * 1024 + 512) : "memory"); }
        asm volatile("s_waitcnt lgkmcnt(0)" ::: "memory"); SBAR();
#define PK(k) (bf16x8){lo[k][0], lo[k][1], lo[k][2], lo[k][3], hi[k][0], hi[k][1], hi[k][2], hi[k][3]}
        o[d0] = __builtin_amdgcn_mfma_f32_32x32x16_bf16(pa0, PK(0), o[d0], 0, 0, 0);
        o[d0] = __builtin_amdgcn_mfma_f32_32x32x16_bf16(pa1, PK(1), o[d0], 0, 0, 0);
        o[d0] = __builtin_amdgcn_mfma_f32_32x32x16_bf16(pa2, PK(2), o[d0], 0, 0, 0);
        o[d0] = __builtin_amdgcn_mfma_f32_32x32x16_bf16(pa3, PK(3), o[d0], 0, 0, 0);
#undef PK
    }
}
#define ATTN_STORE16(p, v) (*(u32x4*)(p) = (v))
template <int THRL> __device__ __forceinline__ void attn_unit(const bf16* Qw0, const bf16* __restrict__ Kh, const bf16* __restrict__ Vh, bf16* Ow0, char* shm) {
    const int tid = mk::fresh_tid(), lane = tid & 63, r32 = lane & 31, hi = lane >> 5; const int wid = __builtin_amdgcn_readfirstlane(tid >> 6);
    const bf16* Qw = Qw0 + (long)(wid * QBLK) * DM;
    const unsigned lds0 = (unsigned)(uintptr_t)shm;
    float* wsf = (float*)(shm + LDS_WS) + wid * 64;
    const bf16* ksrc = Kh + (long)lane * KP + wid * 8;
    const bf16* vsrc = Vh + (long)(16 * (wid & 3) + (lane >> 2)) * KP + (wid >> 2) * 32 + (lane & 3) * 8;
    const unsigned kdst = lds0 + LDS_K + wid * 1024, vdst = lds0 + LDS_V + wid * 1024;
#define DMA_K(t, slot) glds16(ksrc + (long)(t) * KVBLK * KP, (unsigned)__builtin_amdgcn_readfirstlane(kdst + (slot)))
#define DMA_V(t, slot) glds16(vsrc + (long)(t) * KVBLK * KP, (unsigned)__builtin_amdgcn_readfirstlane(vdst + (slot)))
    const int vb0 = (int)(lds0 + LDS_V) + ((lane >> 4) & 1) * 32 + (lane & 3) * 8 + (4 * hi + ((lane & 15) >> 2)) * 64;
    const char* Kbase = shm + LDS_K; bf16x8 kf[8];
    const lds_cptr shm3 = (lds_cptr)shm; const lds_cptr kp0 = shm3 + LDS_K + hi * 1024 + r32 * 16; const lds_cptr vp0 = shm3 + LDS_V + ((lane >> 4) & 1) * 32 + (lane & 3) * 8 + (4 * hi + ((lane & 15) >> 2)) * 64;
    DMA_K(0, 0); DMA_V(0, 0); DMA_K(1, SLOTB);
    bf16x8 qr[4];
#pragma unroll
    for (int d0 = 0; d0 < 4; ++d0) qr[d0] = *reinterpret_cast<const bf16x8*>(&Qw[(long)r32 * DM + d0 * 16 + hi * 8]);
    float mhat = 0.f, l_reg = 0.f; f32x16 o[2]; o[0] = f32x16{}; o[1] = f32x16{}; f32x16 negm = f32x16{}; asm volatile("" : "+v"(negm));
    bool resc = false;
#define START(P0, P1) do { const float rm = rowmax(P0, P1); resc = false; \
    { const float dl = rm; mhat = fadd_s(mhat, dl); \
      _Pragma("unroll") for (int r = 0; r < 16; ++r) { P0[r] = fsub_s(P0[r], dl); P1[r] = fsub_s(P1[r], dl); } \
      _Pragma("unroll") for (int r = 0; r < 16; ++r) negm[r] = -mhat; asm volatile("" : "+v"(negm)); } \
    _Pragma("unroll") for (int r = 0; r < 16; ++r) P0[r] = __builtin_amdgcn_exp2f(P0[r]); } while (0)
#define RESC() do { if (resc) { asm volatile("s_waitcnt lgkmcnt(0)" ::: "memory"); \
      _Pragma("unroll") for (int d_ = 0; d_ < 2; ++d_) _Pragma("unroll") for (int r = 0; r < 16; ++r) o[d_][r] *= wsf[crow(r, hi)]; } } while (0)
    f32x16 pA0, pA1, pB0, pB1;
    int sl_prev = 0, sl_cur = 0, sl_next = SLOTB;
#define ROT() do { sl_prev = sl_cur; sl_cur = sl_next; sl_next = (sl_next == (NSLOT - 1) * SLOTB) ? 0 : sl_next + SLOTB; } while (0)
    DMA_K(2, 2 * SLOTB);
    WAIT_BAR(3);
    qkt(pA0, pA1, Kbase, qr, negm, r32, hi); asm volatile("s_nop 15\n\ts_nop 7" : "+v"(pA0), "+v"(pA1));
    START(pA0, pA1);
    _Pragma("unroll") for (int r = 0; r < 16; ++r) pA1[r] = __builtin_amdgcn_exp2f(pA1[r]);
    WAIT_BAR(0);
    DMA_K(3, 0); DMA_V(1, SLOTB);
    ROT();
    kload8(kf, kp0 + sl_cur);
    WAIT_BAR(2);
    s16x4 vlo[8], vhi[8]; u32x4 pw0, pw1, pw2, pw3;
#define PKW(P, B) cvtpk_s(P[B], P[B + 1])
#define PAF(k) __builtin_bit_cast(bf16x8, pw##k)
#define VFR(i) (bf16x8){vlo[i][0], vlo[i][1], vlo[i][2], vlo[i][3], vhi[i][0], vhi[i][1], vhi[i][2], vhi[i][3]}
#define PIN(x) asm volatile("" : "+v"(x))
#define MX3(a, b, c) __builtin_fmaxf(__builtin_fmaxf((a), (b)), (c))
#define GAPA(MF, A0, A1, A2, A3, W0, W1, PW) do { MF; sacc += A0; sacc += A1; sacc += A2; sacc += A3; PIN(sacc); W0; W1; PIN(PW); SBAR(); } while (0)
#define EX(v) __builtin_amdgcn_exp2f(v)
#define GAPB(MF, X, B) do { MF; X[B] = EX(X[B]); X[B + 1] = EX(X[B + 1]); X[B + 2] = EX(X[B + 2]); X[B + 3] = EX(X[B + 3]); PIN(X); SBAR(); } while (0)
#define VRD(i) do { vlo[i] = vtr(vp_ + (((i) >> 2) * 4096 + ((i) & 3) * 1024)); vhi[i] = vtr(vp_ + (((i) >> 2) * 4096 + ((i) & 3) * 1024 + 512)); } while (0)
#define KRD(G, j) do { if (G) { kload2(kf, kp0 + sl_next, j); SBAR(); } } while (0)
#define STEP(C0, C1, P0, P1, t, GK, GV, GL) do { SBAR(); \
    const lds_cptr vp_ = vp0 + sl_prev; \
    VRD(0); SBAR(); float sacc = (P0[0] + P0[1]); \
    GAPA(C0 = __builtin_amdgcn_mfma_f32_32x32x16_bf16(kf[0], qr[0], negm, 0, 0, 0), P0[2], P0[3], P0[4], P0[5],     pw0[0] = PKW(P0, 0), pw0[1] = PKW(P0, 2), pw0); \
    VRD(4); SBAR(); GAPA(C1 = __builtin_amdgcn_mfma_f32_32x32x16_bf16(kf[1], qr[0], negm, 0, 0, 0), P0[6], P0[7], P0[8], P0[9],     pw0[2] = PKW(P0, 4), pw0[3] = PKW(P0, 6), pw0); \
    VRD(1); SBAR(); GAPA(C0 = __builtin_amdgcn_mfma_f32_32x32x16_bf16(kf[2], qr[1], C0, 0, 0, 0),   P0[10], P0[11], P0[12], P0[13], pw1[0] = PKW(P0, 8), pw1[1] = PKW(P0, 10), pw1); \
    VRD(5); SBAR(); GAPA(C1 = __builtin_amdgcn_mfma_f32_32x32x16_bf16(kf[3], qr[1], C1, 0, 0, 0),   P0[14], P0[15], P1[0], P1[1],   pw1[2] = PKW(P0, 12), pw1[3] = PKW(P0, 14), pw1); \
    VRD(2); SBAR(); GAPA(C0 = __builtin_amdgcn_mfma_f32_32x32x16_bf16(kf[4], qr[2], C0, 0, 0, 0),   P1[2], P1[3], P1[4], P1[5],     pw2[0] = PKW(P1, 0), pw2[1] = PKW(P1, 2), pw2); \
    VRD(6); SBAR(); GAPA(C1 = __builtin_amdgcn_mfma_f32_32x32x16_bf16(kf[5], qr[2], C1, 0, 0, 0),   P1[6], P1[7], P1[8], P1[9],     pw2[2] = PKW(P1, 4), pw2[3] = PKW(P1, 6), pw2); \
    VRD(3); SBAR(); GAPA(C0 = __builtin_amdgcn_mfma_f32_32x32x16_bf16(kf[6], qr[3], C0, 0, 0, 0),   P1[10], P1[11], P1[12], P1[13], pw3[0] = PKW(P1, 8), pw3[1] = PKW(P1, 10), pw3); \
    VRD(7); SBAR(); GAPA(C1 = __builtin_amdgcn_mfma_f32_32x32x16_bf16(kf[7], qr[3], C1, 0, 0, 0),   P1[14], P1[15], 0.f, 0.f,       pw3[2] = PKW(P1, 12), pw3[3] = PKW(P1, 14), pw3); \
    l_reg += sacc; \
    if (GK) { DMA_K((t) + 3, sl_cur); } if (GV) { DMA_V((t) + 1, sl_next); } \
    { float a = MX3(C0[0], C0[1], C1[0]), b = MX3(C0[2], C0[3], C1[1]); a = MX3(a, C1[2], C1[3]); \
      _Pragma("unroll") for (int r = 4; r < 16; r += 4) { a = MX3(a, C0[r], C0[r + 1]); b = MX3(b, C0[r + 2], C0[r + 3]); a = MX3(a, C1[r], C1[r + 1]); b = MX3(b, C1[r + 2], C1[r + 3]); } \
      float rm = __builtin_fmaxf(a, b); { auto rr = __builtin_amdgcn_permlane32_swap(__float_as_uint(rm), __float_as_uint(rm), false, false); rm = __builtin_fmaxf(__uint_as_float(rr[0]), __uint_as_float(rr[1])); } \
      resc = false; \
      if (__builtin_expect(__any(rm > (float)THRL), 0)) { const float dl = __builtin_fmaxf(rm, 0.f); mhat += dl; \
        _Pragma("unroll") for (int r = 0; r < 16; ++r) { C0[r] -= dl; C1[r] -= dl; } \
        _Pragma("unroll") for (int r = 0; r < 16; ++r) negm[r] = -mhat; asm volatile("" : "+v"(negm)); \
        const float f = __builtin_amdgcn_exp2f(-dl); l_reg *= f; if (hi == 0) wsf[r32] = f; resc = true; } } \
    SBAR(); \
    GAPB(o[0] = __builtin_amdgcn_mfma_f32_32x32x16_bf16(PAF(0), VFR(0), o[0], 0, 0, 0), C0, 0); \
    GAPB(o[1] = __builtin_amdgcn_mfma_f32_32x32x16_bf16(PAF(0), VFR(4), o[1], 0, 0, 0), C0, 4); \
    KRD(GL, 0); GAPB(o[0] = __builtin_amdgcn_mfma_f32_32x32x16_bf16(PAF(1), VFR(1), o[0], 0, 0, 0), C0, 8); \
    KRD(GL, 1); GAPB(o[1] = __builtin_amdgcn_mfma_f32_32x32x16_bf16(PAF(1), VFR(5), o[1], 0, 0, 0), C0, 12); \
    KRD(GL, 2); GAPB(o[0] = __builtin_amdgcn_mfma_f32_32x32x16_bf16(PAF(2), VFR(2), o[0], 0, 0, 0), C1, 0); \
    KRD(GL, 3); GAPB(o[1] = __builtin_amdgcn_mfma_f32_32x32x16_bf16(PAF(2), VFR(6), o[1], 0, 0, 0), C1, 4); \
    GAPB(o[0] = __builtin_amdgcn_mfma_f32_32x32x16_bf16(PAF(3), VFR(3), o[0], 0, 0, 0), C1, 8); \
    GAPB(o[1] = __builtin_amdgcn_mfma_f32_32x32x16_bf16(PAF(3), VFR(7), o[1], 0, 0, 0), C1, 12); \
    } while (0)
    int t = 1;
    for (; t + 5 < NT; t += 2) {
        STEP(pB0, pB1, pA0, pA1, t, true, true, true);     WAIT_BAR(2); RESC(); ROT();
        STEP(pA0, pA1, pB0, pB1, t + 1, true, true, true); WAIT_BAR(2); RESC(); ROT();
    }
#define ENDW(tt) do { if ((tt) + 3 < NT) { WAIT_BAR(2); } else if ((tt) + 2 < NT) { WAIT_BAR(1); } else { WAIT_BAR(0); } } while (0)
    for (; t + 1 < NT; t += 2) {
        STEP(pB0, pB1, pA0, pA1, t, (t + 3 < NT), (t + 1 < NT), (t + 1 < NT));         ENDW(t);     RESC(); ROT();
        STEP(pA0, pA1, pB0, pB1, t + 1, (t + 4 < NT), (t + 2 < NT), (t + 2 < NT));     ENDW(t + 1); RESC(); ROT();
    }
    STEP(pB0, pB1, pA0, pA1, NT - 1, false, false, false); RESC();
    { float sacc = pB0[0] + pB0[1]; _Pragma("unroll") for (int r = 2; r < 16; ++r) sacc += pB0[r]; _Pragma("unroll") for (int r = 0; r < 16; ++r) sacc += pB1[r]; l_reg += sacc;
      pw0 = (u32x4){PKW(pB0, 0), PKW(pB0, 2), PKW(pB0, 4), PKW(pB0, 6)}; pw1 = (u32x4){PKW(pB0, 8), PKW(pB0, 10), PKW(pB0, 12), PKW(pB0, 14)}; pw2 = (u32x4){PKW(pB1, 0), PKW(pB1, 2), PKW(pB1, 4), PKW(pB1, 6)}; pw3 = (u32x4){PKW(pB1, 8), PKW(pB1, 10), PKW(pB1, 12), PKW(pB1, 14)};
      SBAR(); pv(o, vb0 + sl_cur, PAF(0), PAF(1), PAF(2), PAF(3)); }
#undef PKW
#undef PAF
#undef VFR
#undef PIN
#undef MX3
#undef GAPA
#undef GAPB
#undef EX
#undef VRD
#undef KRD
#undef STEP
#undef ENDW
    { auto rr = __builtin_amdgcn_permlane32_swap(__float_as_uint(l_reg), __float_as_uint(l_reg), false, false); l_reg = __uint_as_float(rr[0]) + __uint_as_float(rr[1]); }
    if (hi == 0) wsf[32 + r32] = l_reg; asm volatile("s_waitcnt lgkmcnt(0)" ::: "memory");
    float rli[16];
#pragma unroll
    for (int r = 0; r < 16; ++r) rli[r] = __builtin_amdgcn_rcpf(wsf[32 + crow(r, hi)]);
    bf16* Ow = Ow0 + (long)(wid * QBLK) * DM;
    { bf16* stg = (bf16*)(shm + LDS_OST) + wid * 2048;
#pragma unroll
      for (int r = 0; r < 16; ++r) { const int orow = crow(r, hi);
#pragma unroll
          for (int d0 = 0; d0 < 2; ++d0) { const unsigned pk = cvtpk_s(o[d0][r] * rli[r], 0.f); stg[orow * 64 + d0 * 32 + r32] = (bf16)(pk & 0xffffu); } }
      asm volatile("s_waitcnt lgkmcnt(0)" ::: "memory");
#pragma unroll
      for (int i = 0; i < 4; ++i) { const int row = i * 8 + (lane >> 3), ch = lane & 7; const u32x4 v = *(const u32x4*)(stg + row * 64 + ch * 8); ATTN_STORE16(Ow + (long)row * DM + ch * 8, v); } }
    asm volatile("s_waitcnt lgkmcnt(0)\n\ts_barrier" ::: "memory");
#undef DMA_K
#undef DMA_V
#undef START
#undef RESC
#undef ROT
}
#undef SBAR
#undef WAIT_BAR
}

#ifndef MK_PHMASK
#define MK_PHMASK 0xffffffffu
#endif
#define PHON(k) (((MK_PHMASK) >> (k)) & 1u)
struct Args { const float* in[29]; float* out; unsigned char* ws; int ph_lo, ph_hi, dry, pad; };
static_assert(sizeof(Args) == 29 * 8 + 8 + 8 + 16, "Args has no padding");

template <int LAYER> __device__ __forceinline__ void moe_phases(Frame& F, const XcdBarrier& bar, int lo, int hi, int k0, int nrows) {
#define IN(k) (PHON(k) && lo <= (k) && (k) < hi)
#define BOTH(k) (IN(k) && (lo <= (k) + 1 && (k) + 1 < hi))
    if (IN(k0)) { route_phase(F, LAYER, nrows); if (BOTH(k0)) xcd_barrier(bar); }
    if (IN(k0 + 1)) {
        const int ntile = moe_table(F, LAYER);
        Moe1Sched S; S.m.tab = (const volatile LAS int*)(F.lds + TAB_OFF); S.m.vcu = F.vcu; S.m.G = F.G; S.m.ntile = ntile;
        S.H2 = (const char*)(F.ws + WS_H2); S.Wgu = (const char*)(F.ws + WS_WGU) + (size_t)LAYER * 16 * 512 * 2048; S.list = (const i32x4*)(F.ws + WS_LIST);
        EpiMoe1 E; E.F = &F;
        pg8::Gemm g{2048, 2048, 16, 16};
        pg8::gemm_phase<EpiMoe1, Moe1Sched, true>(F.lds, g, S, E);
        if (BOTH(k0 + 1)) xcd_barrier(bar);
    }
    if (IN(k0 + 2)) {
        const int ntile = moe_table(F, LAYER);
        Moe2Sched S; S.m.tab = (const volatile LAS int*)(F.lds + TAB_OFF); S.m.vcu = F.vcu; S.m.G = F.G; S.m.ntile = ntile;
        S.HID = (const char*)(F.ws + WS_HID); S.Wd = (const char*)(F.ws + WS_WD) + (size_t)LAYER * 16 * 1024 * 512; S.list = (const i32x4*)(F.ws + WS_LIST);
        EpiMoe2<LAYER == 3> E; E.F = &F; E.layer = LAYER;
        pg8::Gemm g{1024, 512, 8, 4};
        pg8::gemm_phase<EpiMoe2<LAYER == 3>, Moe2Sched, true>(F.lds, g, S, E);
        if (BOTH(k0 + 2)) xcd_barrier(bar);
    }
#undef IN
#undef BOTH
}

__global__ void __launch_bounds__(NTHR, 2) mk_fwd(Args args) {
    extern __shared__ __attribute__((aligned(16))) unsigned char lds_raw[];
    Frame F;
    F.lds = (LAS unsigned char*)lds_raw;
    F.MISC = (volatile LAS unsigned*)(F.lds + MISC_OFF);
    F.G = gridDim.x; { const int bx = blockIdx.x; F.vcu = (F.G % 8 == 0) ? (bx % 8) * (F.G / 8) + bx / 8 : bx; }
#pragma unroll
    for (int i = 0; i < 29; ++i) F.in[i] = args.in[i];
    F.out = args.out; F.ws = args.ws; F.dry = args.dry; F.ctl = (gu32*)(args.ws + WS_CTL);
    for (int u = threadIdx.x; u < (LDS_BYTES - LDSCTL_OFF) / 4; u += NTHR) ((LAS unsigned*)(F.lds + LDSCTL_OFF))[u] = 0u;
    __syncthreads();
    const int lo = args.ph_lo, hi = args.ph_hi;
    XcdBarrier bar; bar.bar = (unsigned*)(F.ctl + CW_BAR); bar.x = 0; bar.st = nullptr;
    if (hi - lo > 1) bar = xcd_barrier_post((unsigned*)(F.ctl + CW_BAR), F.MISC + 8);
#define IN(k) (PHON(k) && lo <= (k) && (k) < hi)
#define BOTH(k) (IN(k) && (lo <= (k) + 1 && (k) + 1 < hi))
#define GRID_BAR(k) do { if (BOTH(k)) xcd_barrier(bar); } while (0)
    if (IN(0)) { p0_prologue(F); GRID_BAR(0); }
    if (IN(1)) { pool_phase(F, 0, NROW / 64); GRID_BAR(1); }
    if (IN(2)) {
        DenseSched S; S.A = (const char*)(F.ws + WS_A); S.B = (const char*)(F.ws + WS_WPOOL); S.nN = 4; S.nunits = (NROW / 256) * 4; S.vcu = F.vcu; S.G = F.G; S.a_tile = 256 * 2048; S.b_tile = 256 * 512; S.a_coloff = 512; S.pm0 = 0;
        EpiResid E; E.F = &F; E.layer = 0; E.bias = F.in[I_POOLB]; E.mul = F.in[I_POOLLS];
        pg8::Gemm g{2048, 512, 4, 4};
        pg8::gemm_phase<EpiResid, DenseSched, true>(F.lds, g, S, E);
        GRID_BAR(2);
    }
    moe_phases<0>(F, bar, lo, hi, 3, NROW);
    if (IN(6)) { norm_phase(F, 1, NROW); GRID_BAR(6); }
    if (IN(7)) {
        QkvSched S; S.A = (const char*)(F.ws + WS_A); S.B = (const char*)(F.ws + WS_WQKV); S.vcu = F.vcu; S.G = F.G;
        EpiQkv E; E.F = &F; E.qg = F.in[I_QG]; E.kg = F.in[I_KG];
        pg8::Gemm g{2048, 2048, 16, 16};
        pg8::gemm_phase<EpiQkv, QkvSched, true>(F.lds, g, S, E);
        GRID_BAR(7);
    }
    if (IN(8)) {
        const attn_body::bf16* Q = (const attn_body::bf16*)(F.ws + WS_Q); const attn_body::bf16* K = (const attn_body::bf16*)(F.ws + WS_K); const attn_body::bf16* V = (const attn_body::bf16*)(F.ws + WS_V);
        attn_body::bf16* O = (attn_body::bf16*)(F.ws + WS_A);
        const int x = F.vcu >> 5, j = F.vcu & 31;
        for (int i = 0; i < 8; ++i) {
            const int combo = x * 4 + (i >> 1), sub = (i & 1) * 32 + j, gq = sub >> 4, qb = sub & 15, b = combo >> 2, hkv = combo & 3, h = hkv * 4 + gq;
            const size_t qrow = (size_t)b * SEQ + qb * 256;
            attn_body::attn_unit<8>(Q + qrow * D + h * 64, K + (size_t)b * KVROWS * KVP + hkv * 64, V + (size_t)b * KVROWS * KVP + hkv * 64, O + qrow * D + h * 64, (char*)lds_raw);
        }
        GRID_BAR(8);
    }
    if (IN(9)) {
        DenseSched S; S.A = (const char*)(F.ws + WS_A); S.B = (const char*)(F.ws + WS_WO); S.nN = 4; S.nunits = (NLAT / 256) * 4; S.vcu = F.vcu; S.G = F.G; S.a_tile = 256 * 2048; S.b_tile = 256 * 2048; S.a_coloff = 0; S.pm0 = 0;
        EpiResid E; E.F = &F; E.layer = 1; E.bias = nullptr; E.mul = nullptr;
        pg8::Gemm g{2048, 2048, 16, 16};
        pg8::gemm_phase<EpiResid, DenseSched, true>(F.lds, g, S, E);
        GRID_BAR(9);
    }
    moe_phases<1>(F, bar, lo, hi, 10, NLAT);
    if (IN(13)) { norm_phase(F, 2, NLAT); GRID_BAR(13); }
    if (IN(14)) {
        DenseSched S; S.A = (const char*)(F.ws + WS_A); S.B = (const char*)(F.ws + WS_WIN); S.nN = 8; S.nunits = (NLAT / 256) * 8; S.vcu = F.vcu; S.G = F.G; S.a_tile = 256 * 2048; S.b_tile = 256 * 2048; S.a_coloff = 0; S.pm0 = 0;
        EpiSgu1 E; E.F = &F; E.bin = F.in[I_BIN];
        pg8::Gemm g{2048, 2048, 16, 16};
        pg8::gemm_phase<EpiSgu1, DenseSched, true>(F.lds, g, S, E);
        GRID_BAR(14);
    }
    if (IN(15)) { sgu_spatial_phase(F); GRID_BAR(15); }
    if (IN(16)) {
        DenseSched S; S.A = (const char*)(F.ws + WS_A); S.B = (const char*)(F.ws + WS_WOUT); S.nN = 4; S.nunits = (NLAT / 256) * 4; S.vcu = F.vcu; S.G = F.G; S.a_tile = 256 * 2048; S.b_tile = 256 * 2048; S.a_coloff = 0; S.pm0 = 0;
        EpiResid E; E.F = &F; E.layer = 2; E.bias = nullptr; E.mul = nullptr;
        pg8::Gemm g{2048, 2048, 16, 16};
        pg8::gemm_phase<EpiResid, DenseSched, true>(F.lds, g, S, E);
        GRID_BAR(16);
    }
    moe_phases<2>(F, bar, lo, hi, 17, NLAT);
    if (IN(20)) { pool_phase(F, 3, NLAT / 64); GRID_BAR(20); }
    if (IN(21)) {
        DenseSched S; S.A = (const char*)(F.ws + WS_A); S.B = (const char*)(F.ws + WS_WPOOL) + (size_t)4 * 256 * 512; S.nN = 4; S.nunits = (NLAT / 256) * 4; S.vcu = F.vcu; S.G = F.G; S.a_tile = 256 * 2048; S.b_tile = 256 * 512; S.a_coloff = 512; S.pm0 = 0;
        EpiResid E; E.F = &F; E.layer = 3; E.bias = F.in[I_POOLB] + 1024; E.mul = F.in[I_POOLLS] + 1024;
        pg8::Gemm g{2048, 512, 4, 4};
        pg8::gemm_phase<EpiResid, DenseSched, true>(F.lds, g, S, E);
        GRID_BAR(21);
    }
    moe_phases<3>(F, bar, lo, hi, 22, NLAT);
#undef IN
#undef BOTH
#undef GRID_BAR
}

static int g_grid = 0;
static bool mk_setup() {
    if (g_grid) return g_grid > 0;
    int dev = 0, cus = 0;
    if (hipGetDevice(&dev) != hipSuccess || hipDeviceGetAttribute(&cus, hipDeviceAttributeMultiprocessorCount, dev) != hipSuccess) { g_grid = -1; return false; }
    if (hipFuncSetAttribute((const void*)mk_fwd, hipFuncAttributeMaxDynamicSharedMemorySize, LDS_BYTES) != hipSuccess) { g_grid = -1; return false; }
    int per_cu = 0; (void)hipOccupancyMaxActiveBlocksPerMultiprocessor(&per_cu, (const void*)mk_fwd, NTHR, LDS_BYTES); (void)hipGetLastError();
    if (per_cu < 1) fprintf(stderr, "mk: occupancy query says %d blocks per CU\n", per_cu);
    g_grid = cus;
    return true;
}
static void mk_launch_range(void* const* d_in, void* d_out, void* d_ws, hipStream_t stream, int lo, int hi, int dry = 0) {
    Args a{};
    for (int i = 0; i < 29; ++i) a.in[i] = (const float*)d_in[i];
    a.out = (float*)d_out; a.ws = (unsigned char*)d_ws; a.ph_lo = lo; a.ph_hi = hi; a.dry = dry; a.pad = 0;
    hipLaunchKernelGGL(mk_fwd, dim3(g_grid), dim3(NTHR), LDS_BYTES, stream, a);
}
}
extern "C" void kernel_launch(void* const* d_in, const int* in_sizes, int n_in, void* d_out, int out_size, void* d_ws, size_t ws_size, hipStream_t stream) {
    if (!mk::mk_setup()) return;
    hipMemsetAsync((char*)d_ws + mk::WS_CTL, 0, mk::CTL_ZERO_BYTES, stream);
    mk::mk_launch_range(d_in, d_out, d_ws, stream, 0, mk::NPHASE);
}
```
